# Optimizing an MI355X kernel written in HIP

```python
import math
import jax, jax.numpy as jnp
from jax import lax
import numpy as np

D_MODEL = 1024
BATCH = 32
SEQ = 256
DEPTH = 4
DEC_BATCH = 8
DEC_SEQ = 1024
PAST_LEN = 512

GRID_W = 64
CHUNK = 128
Q_BLOCK = 128
EPS = 1e-6

H_SSD = 8
P_SSD = 64
D_SSD = H_SSD * P_SSD
G_SSD = 2
N_SSD = 64
CONV_W = 5
CONV_DIM = D_SSD + 2 * G_SSD * N_SSD
SSD_PROJ = D_SSD + CONV_DIM + 2 * H_SSD

H_RET = 4
DK_RET = 64
DV_RET = 64
D_RET = H_RET * DV_RET
RET_PROJ = 2 * H_RET * DK_RET + 2 * H_RET * DV_RET

H_MLA = 4
Q_RANK = 256
KV_RANK = 128
NOPE_DIM = 64
ROPE_DIM = 32
V_DIM = 64
D_MLA = H_MLA * V_DIM
MLA_PROJ = Q_RANK + KV_RANK + ROPE_DIM
ROPE_BASE = 10000.0

D_MIX = D_SSD + D_RET + D_MLA
D_IN = SSD_PROJ + RET_PROJ + MLA_PROJ
D_FF = -(-8 * D_MODEL // (3 * 256)) * 256

kernel_name = 'hybrid_ssd_retention_mla_diffusion_step'


def _rmsnorm(x, w):
    xf = x.astype(jnp.float32)
    y = xf * lax.rsqrt(jnp.mean(xf * xf, axis=-1, keepdims=True) + EPS)
    return (y * w.astype(jnp.float32)).astype(x.dtype)


def _modulation(cond, w_ada, b_ada):
    m = jax.nn.silu(cond) @ w_ada + b_ada
    return jnp.split(m[:, None, :], 6, axis=-1)


def _dwconv(x, w, b):
    ch = x.shape[-1]
    y = lax.conv_general_dilated(x, w[:, None, :].astype(x.dtype), window_strides=(1,),
                                 padding=[(CONV_W // 2, CONV_W // 2)],
                                 dimension_numbers=('NWC', 'WIO', 'NWC'), feature_group_count=ch)
    return y + b.astype(x.dtype)


def _chunked_scan(q, k, v, log_a, h0):
    f32 = jnp.float32
    b, L, nh, n = q.shape
    p = v.shape[-1]
    nc = L // CHUNK
    qc = q.astype(f32).reshape(b, nc, CHUNK, nh, n)
    kc = k.astype(f32).reshape(b, nc, CHUNK, nh, n)
    vc = v.astype(f32).reshape(b, nc, CHUNK, nh, p)
    cum = lax.cumsum(log_a.astype(f32).reshape(b, nc, CHUNK, nh), axis=2)
    idx = jnp.arange(CHUNK)
    lower = (idx[:, None] >= idx[None, :])[None, None, :, :, None]
    seg = cum[:, :, :, None, :] - cum[:, :, None, :, :]
    decay = jnp.exp(jnp.where(lower, seg, -jnp.inf))
    scores = jnp.einsum('bcihn,bcjhn->bcijh', qc, kc) * decay
    y_intra = jnp.einsum('bcijh,bcjhp->bcihp', scores, vc)
    to_end = jnp.exp(cum[:, :, -1:, :] - cum)
    chunk_state = jnp.einsum('bclhn,bclh,bclhp->bchnp', kc, to_end, vc)
    chunk_decay = jnp.exp(cum[:, :, -1, :])

    def step(h_prev, inp):
        cs, cd = inp
        return h_prev * cd[..., None, None] + cs, h_prev

    h_fin, h_enter = lax.scan(step, h0.astype(f32),
                              (jnp.swapaxes(chunk_state, 0, 1), jnp.swapaxes(chunk_decay, 0, 1)))
    h_enter = jnp.swapaxes(h_enter, 0, 1)
    y_inter = jnp.einsum('bcihn,bchnp,bcih->bcihp', qc, h_enter, jnp.exp(cum))
    y = (y_intra + y_inter).reshape(b, L, nh, p)
    return y.astype(q.dtype), h_fin.astype(h0.dtype)


def _directional_scan(q, k, v, log_a, h0, reverse):
    if reverse:
        q, k, v, log_a = (jnp.flip(t, axis=1) for t in (q, k, v, log_a))
    y, h = _chunked_scan(q, k, v, log_a, h0)
    if reverse:
        y = jnp.flip(y, axis=1)
    return y, h


def _ssd(u, conv_w, conv_b, dt_bias, a_log, d_skip, norm_w, h0):
    b, L, _ = u.shape
    z = u[..., :D_SSD]
    xbc = jax.nn.silu(_dwconv(u[..., D_SSD:D_SSD + CONV_DIM], conv_w, conv_b))
    xs = xbc[..., :D_SSD].reshape(b, L, H_SSD, P_SSD)
    bm = xbc[..., D_SSD:D_SSD + G_SSD * N_SSD].reshape(b, L, G_SSD, N_SSD)
    cm = xbc[..., D_SSD + G_SSD * N_SSD:].reshape(b, L, G_SSD, N_SSD)
    bh = jnp.repeat(bm, H_SSD // G_SSD, axis=2)
    ch = jnp.repeat(cm, H_SSD // G_SSD, axis=2)
    dt = jax.nn.softplus((u[..., D_SSD + CONV_DIM:].reshape(b, L, 2, H_SSD) + dt_bias).astype(jnp.float32))
    a = -jnp.exp(a_log.astype(jnp.float32))
    y_f, h_f = _directional_scan(ch, bh, xs * dt[:, :, 0, :, None], dt[:, :, 0] * a[0], h0[:, 0], False)
    y_b, h_b = _directional_scan(ch, bh, xs * dt[:, :, 1, :, None], dt[:, :, 1] * a[1], h0[:, 1], True)
    y = (y_f + y_b + d_skip[:, None] * xs).reshape(b, L, D_SSD) * jax.nn.silu(z)
    return _rmsnorm(y.astype(u.dtype), norm_w), jnp.stack([h_f, h_b], axis=1)


def _retention(u, decay_logit, gn_w, h0):
    b, L, _ = u.shape
    nq = H_RET * DK_RET
    q = u[..., :nq].reshape(b, L, H_RET, DK_RET)
    k = u[..., nq:2 * nq].reshape(b, L, H_RET, DK_RET) * (DK_RET ** -0.5)
    v = u[..., 2 * nq:2 * nq + D_RET].reshape(b, L, H_RET, DV_RET)
    g = u[..., 2 * nq + D_RET:]
    log_gamma = jax.nn.log_sigmoid(decay_logit.astype(jnp.float32))
    o_f, s_f = _directional_scan(q, k, v, jnp.broadcast_to(log_gamma[0], (b, L, H_RET)), h0[:, 0], False)
    o_b, s_b = _directional_scan(q, k, v, jnp.broadcast_to(log_gamma[1], (b, L, H_RET)), h0[:, 1], True)
    of = (o_f + o_b).astype(jnp.float32)
    mu = jnp.mean(of, axis=-1, keepdims=True)
    var = jnp.mean(jnp.square(of - mu), axis=-1, keepdims=True)
    on = ((of - mu) * lax.rsqrt(var + EPS)).reshape(b, L, D_RET) * gn_w.astype(jnp.float32)
    return (jax.nn.silu(g) * on).astype(u.dtype), jnp.stack([s_f, s_b], axis=1)


def _axial_rope(n_tokens):
    n_rows = n_tokens // GRID_W
    row, col = jnp.meshgrid(jnp.arange(n_rows), jnp.arange(GRID_W), indexing='ij')
    row = row.reshape(-1).astype(jnp.float32)
    col = col.reshape(-1).astype(jnp.float32)
    half = ROPE_DIM // 2
    inv = ROPE_BASE ** (-jnp.arange(0, half, 2, dtype=jnp.float32) / half)
    ang_r = row[:, None] * inv
    ang_c = col[:, None] * inv
    ang = jnp.concatenate([ang_r, ang_r, ang_c, ang_c], axis=-1)
    return jnp.cos(ang), jnp.sin(ang)


def _rot_half(t):
    t1, t2 = jnp.split(t, 2, axis=-1)
    return jnp.concatenate([-t2, t1], axis=-1)


def _apply_rope(x, cos, sin):
    xr, xc = jnp.split(x, 2, axis=-1)
    rot = jnp.concatenate([_rot_half(xr), _rot_half(xc)], axis=-1)
    out = x.astype(jnp.float32) * cos[:, None, :] + rot.astype(jnp.float32) * sin[:, None, :]
    return out.astype(x.dtype)


def _block_attention(q, k, v):
    b, L, nh, dq = q.shape
    nb = L // Q_BLOCK
    qb = jnp.swapaxes(q.reshape(b, nb, Q_BLOCK, nh, dq), 0, 1)
    scale = dq ** -0.5

    def one_block(qblk):
        s = jnp.einsum('bqhd,bkhd->bhqk', qblk, k).astype(jnp.float32) * scale
        p = jax.nn.softmax(s, axis=-1)
        return jnp.einsum('bhqk,bkhd->bqhd', p.astype(v.dtype), v)

    o = lax.map(one_block, qb)
    return jnp.swapaxes(o, 0, 1).reshape(b, L, nh, v.shape[-1])


def _mla(u, q_norm_w, w_uq, kv_norm_w, w_ukv, rope, ctx_kv):
    b, L, _ = u.shape
    q_c = _rmsnorm(u[..., :Q_RANK], q_norm_w)
    ckv = _rmsnorm(u[..., Q_RANK:Q_RANK + KV_RANK], kv_norm_w)
    krope = u[..., Q_RANK + KV_RANK:]
    q = (q_c @ w_uq).reshape(b, L, H_MLA, NOPE_DIM + ROPE_DIM)
    q_nope, q_rope = q[..., :NOPE_DIM], q[..., NOPE_DIM:]
    if ctx_kv is None:
        ckv_all, kr_all = ckv, krope
    else:
        cos, sin = rope
        q_rope = _apply_rope(q_rope, cos, sin)
        kr_lat = _apply_rope(krope[:, :, None, :], cos, sin)[:, :, 0]
        ckv_all = jnp.concatenate([ctx_kv[0].astype(ckv.dtype), ckv], axis=1)
        kr_all = jnp.concatenate([ctx_kv[1].astype(kr_lat.dtype), kr_lat], axis=1)
    s_len = ckv_all.shape[1]
    kv = (ckv_all @ w_ukv).reshape(b, s_len, H_MLA, NOPE_DIM + V_DIM)
    k = jnp.concatenate([kv[..., :NOPE_DIM],
                         jnp.broadcast_to(kr_all[:, :, None, :], (b, s_len, H_MLA, ROPE_DIM)).astype(kv.dtype)], axis=-1)
    v = kv[..., NOPE_DIM:]
    o = _block_attention(jnp.concatenate([q_nope, q_rope], axis=-1), k, v)
    return o.reshape(b, L, D_MLA), ckv, krope


def _layer(x, cond, lp, ctx, rope):
    b = x.shape[0]
    sh1, sc1, g1, sh2, sc2, g2 = _modulation(cond, lp['w_ada'], lp['b_ada'])
    h = _rmsnorm(x, lp['norm1_w']) * (1 + sc1) + sh1
    u = h @ lp['w_in']
    u_ssd = u[..., :SSD_PROJ]
    u_ret = u[..., SSD_PROJ:SSD_PROJ + RET_PROJ]
    u_mla = u[..., SSD_PROJ + RET_PROJ:]
    if ctx is None:
        ssd_h0 = jnp.zeros((b, 2, H_SSD, N_SSD, P_SSD), x.dtype)
        ret_h0 = jnp.zeros((b, 2, H_RET, DK_RET, DV_RET), x.dtype)
        ctx_kv = None
    else:
        ssd_h0, ret_h0, ckv_ctx, kr_ctx = ctx
        ctx_kv = (ckv_ctx, kr_ctx)
    y_ssd, ssd_state = _ssd(u_ssd, lp['ssd_conv_w'], lp['ssd_conv_b'], lp['ssd_dt_bias'], lp['ssd_A_log'],
                            lp['ssd_D'], lp['ssd_norm_w'], ssd_h0)
    y_ret, ret_state = _retention(u_ret, lp['ret_decay_logit'], lp['ret_gn_w'], ret_h0)
    y_mla, ckv, krope = _mla(u_mla, lp['mla_q_norm_w'], lp['mla_w_uq'], lp['mla_kv_norm_w'], lp['mla_w_ukv'],
                             rope, ctx_kv)
    mix = jnp.concatenate([y_ssd.astype(x.dtype), y_ret.astype(x.dtype), y_mla.astype(x.dtype)], axis=-1)
    x = x + g1 * (mix @ lp['w_out'])
    h2 = _rmsnorm(x, lp['norm2_w']) * (1 + sc2) + sh2
    a, gt = jnp.split(h2 @ lp['ffn_w1'], 2, axis=-1)
    x = x + g2 * ((jax.nn.silu(a) * gt) @ lp['ffn_w2'])
    return x, (ssd_state, ret_state, ckv, krope)


def setup_inputs(seed: int = 0) -> dict:
    key = jax.random.key(seed)
    ks = jax.random.split(key, 32)
    f32 = jnp.float32

    def nrm(i, shape, scale):
        return jax.random.normal(ks[i], shape, f32) * scale

    def gain(i, shape):
        return 1.0 + nrm(i, shape, 0.02)

    dt0 = jnp.exp(jax.random.uniform(ks[14], (DEPTH, 2, H_SSD), f32, math.log(1e-3), math.log(1e-1)))
    ret_base = jnp.log(2.0 ** (5.0 + jnp.arange(H_RET, dtype=f32)) - 1.0)
    return {
        'x_prompt': nrm(0, (BATCH, SEQ, D_MODEL), 1.0),
        'x_sample': nrm(1, (DEC_BATCH, DEC_SEQ, D_MODEL), 1.0),
        'c': nrm(2, (DEC_BATCH, D_MODEL), 1.0),
        'state_ssd': nrm(3, (DEC_BATCH, DEPTH, 2, H_SSD, N_SSD, P_SSD), 0.5),
        'state_ret': nrm(4, (DEC_BATCH, DEPTH, 2, H_RET, DK_RET, DV_RET), 0.5),
        'cache_mla_ckv': nrm(5, (DEC_BATCH, DEPTH, PAST_LEN, KV_RANK), 1.0),
        'cache_mla_krope': nrm(6, (DEC_BATCH, DEPTH, PAST_LEN, ROPE_DIM), 1.0),
        'c_ctx': nrm(7, (D_MODEL,), 1.0),
        'w_ada': nrm(8, (DEPTH, D_MODEL, 6 * D_MODEL), 0.5 * D_MODEL ** -0.5),
        'b_ada': nrm(9, (DEPTH, 6 * D_MODEL), 0.01),
        'norm1_w': gain(10, (DEPTH, D_MODEL)),
        'w_in': nrm(11, (DEPTH, D_MODEL, D_IN), D_MODEL ** -0.5),
        'ssd_conv_w': nrm(12, (DEPTH, CONV_W, CONV_DIM), CONV_W ** -0.5),
        'ssd_conv_b': nrm(13, (DEPTH, CONV_DIM), 0.01),
        'ssd_dt_bias': dt0 + jnp.log(-jnp.expm1(-dt0)),
        'ssd_A_log': jnp.log(jax.random.uniform(ks[15], (DEPTH, 2, H_SSD), f32, 1.0, 16.0)),
        'ssd_D': gain(16, (DEPTH, H_SSD)),
        'ssd_norm_w': gain(17, (DEPTH, D_SSD)),
        'ret_decay_logit': ret_base + nrm(18, (DEPTH, 2, H_RET), 0.1),
        'ret_gn_w': gain(19, (DEPTH, D_RET)),
        'mla_q_norm_w': gain(20, (DEPTH, Q_RANK)),
        'mla_w_uq': nrm(21, (DEPTH, Q_RANK, H_MLA * (NOPE_DIM + ROPE_DIM)), Q_RANK ** -0.5),
        'mla_kv_norm_w': gain(22, (DEPTH, KV_RANK)),
        'mla_w_ukv': nrm(23, (DEPTH, KV_RANK, H_MLA * (NOPE_DIM + V_DIM)), KV_RANK ** -0.5),
        'w_out': nrm(24, (DEPTH, D_MIX, D_MODEL), D_MIX ** -0.5),
        'norm2_w': gain(25, (DEPTH, D_MODEL)),
        'ffn_w1': nrm(26, (DEPTH, D_MODEL, 2 * D_FF), D_MODEL ** -0.5),
        'ffn_w2': nrm(27, (DEPTH, D_FF, D_MODEL), D_FF ** -0.5),
        'final_norm_w': gain(28, (D_MODEL,)),
    }


def reference(x_prompt, x_sample, c, state_ssd, state_ret, cache_mla_ckv, cache_mla_krope, c_ctx,
              w_ada, b_ada, norm1_w, w_in, ssd_conv_w, ssd_conv_b, ssd_dt_bias, ssd_A_log, ssd_D, ssd_norm_w,
              ret_decay_logit, ret_gn_w, mla_q_norm_w, mla_w_uq, mla_kv_norm_w, mla_w_ukv, w_out, norm2_w,
              ffn_w1, ffn_w2, final_norm_w):
    stacked = dict(w_ada=w_ada, b_ada=b_ada, norm1_w=norm1_w, w_in=w_in, ssd_conv_w=ssd_conv_w,
                   ssd_conv_b=ssd_conv_b, ssd_dt_bias=ssd_dt_bias, ssd_A_log=ssd_A_log, ssd_D=ssd_D,
                   ssd_norm_w=ssd_norm_w, ret_decay_logit=ret_decay_logit, ret_gn_w=ret_gn_w,
                   mla_q_norm_w=mla_q_norm_w, mla_w_uq=mla_w_uq, mla_kv_norm_w=mla_kv_norm_w,
                   mla_w_ukv=mla_w_ukv, w_out=w_out, norm2_w=norm2_w, ffn_w1=ffn_w1, ffn_w2=ffn_w2)

    xp = x_prompt
    cond_ctx = c_ctx[None, :]
    ssd_list, ret_list, ckv_list, kr_list = [], [], [], []
    for i in range(DEPTH):
        lp = {name: arr[i] for name, arr in stacked.items()}
        xp, (s_ssd, s_ret, ckv, kr) = _layer(xp, cond_ctx, lp, None, None)
        ssd_list.append(s_ssd)
        ret_list.append(s_ret)
        ckv_list.append(ckv)
        kr_list.append(kr)
    y_prompt = _rmsnorm(xp, final_norm_w)

    rope = _axial_rope(x_sample.shape[1])
    xs = x_sample
    for i in range(DEPTH):
        lp = {name: arr[i] for name, arr in stacked.items()}
        ctx = (state_ssd[:, i], state_ret[:, i], cache_mla_ckv[:, i], cache_mla_krope[:, i])
        xs, _ = _layer(xs, c, lp, ctx, rope)
    y_sample = _rmsnorm(xs, final_norm_w)

    return (y_prompt, y_sample, jnp.stack(ssd_list, axis=1), jnp.stack(ret_list, axis=1),
            jnp.stack(ckv_list, axis=1), jnp.stack(kr_list, axis=1))
```

```cpp
#include <hip/hip_runtime.h>
#include <hip/hip_cooperative_groups.h>
#include <cstdio>
#include <cstdint>
namespace cg = cooperative_groups;

#ifndef MK_SINGLE
#define MK_SINGLE 1
#endif

#ifndef PROBE_MIX
#define PROBE_MIX 0
#endif
#ifndef PROBE_NOX
#define PROBE_NOX 0
#endif
#ifndef PROBE_SUB
#define PROBE_SUB -1
#endif
#define LAS __attribute__((address_space(3)))
#define GAS __attribute__((address_space(1)))
typedef unsigned short bf16_t;
typedef short bf16x8 __attribute__((ext_vector_type(8)));
typedef float f32x4 __attribute__((ext_vector_type(4)));
typedef float f32x2 __attribute__((ext_vector_type(2)));
typedef unsigned u32x4 __attribute__((ext_vector_type(4)));
typedef unsigned u32x2 __attribute__((ext_vector_type(2)));

namespace pg8 {
constexpr int BM = 256, BK = 64, HALF = 128, HTB = HALF * BK * 2, STAGE_BYTES = 8 * HTB, NXCD = 8, WGM = 8;
__host__ __device__ __forceinline__ int lds_byte(int r, int c) { const int st = (r >> 4) * 2 + (c >> 5), rr = r & 15, cc = c & 31, ob = rr * 64 + cc * 2; return st * 1024 + (ob ^ (((ob >> 9) & 1) << 5)); }
__host__ __device__ __forceinline__ void stage_rc(int b, int& R, int& C) { const int st = b / 1024, sb = b % 1024, swz = sb ^ (((sb >> 9) & 1) << 5); R = (st >> 1) * 16 + swz / 64; C = (st & 1) * 32 + (swz % 64) / 2; }
__host__ __device__ __forceinline__ int perm32(int rho) { const int n = rho >> 4, i = rho & 15; return 8 * (i >> 2) + 4 * n + (i & 3); }

struct Unit { int pm, pn; };
struct Gemm { const bf16_t* A; const bf16_t* Bt; int M, N, K; };

struct StaticOrder {
    int nM, nN, nwg, G, c;
    __host__ __device__ void init(int M, int N, int G_, int c_) { nM = M / BM; nN = N / BM; nwg = nM * nN; G = G_; c = c_; }
    __host__ __device__ bool next(int i, Unit& u) const {
        const long L = (long)i * G + c; if (L >= nwg) return false;
        int wgid = (int)L; { const int q = nwg / NXCD, r = nwg % NXCD, xcd = wgid % NXCD, off = wgid / NXCD; wgid = (xcd < r ? xcd * (q + 1) : r * (q + 1) + (xcd - r) * q) + off; }
        const int nig = WGM * nN, gid = wgid / nig, fm = gid * WGM, gsz = (nM - fm) < WGM ? (nM - fm) : WGM;
        u.pm = fm + ((wgid % nig) % gsz); u.pn = (wgid % nig) / gsz; return true;
    }
    __device__ __forceinline__ void a_ready(const Unit&) const {}
    __device__ __forceinline__ void done(const Unit&) const {}
};

__device__ __forceinline__ void st16_wt(void* p, u32x4 v) { asm volatile("global_store_dwordx4 %0, %1, off sc1" :: "v"(p), "v"(v) : "memory"); }
__device__ __forceinline__ unsigned cvt_pk_bf16(float lo, float hi) { unsigned r; asm volatile("v_cvt_pk_bf16_f32 %0, %1, %2" : "=v"(r) : "v"(lo), "v"(hi)); return r; }

struct EpiBf16 {
    static constexpr bool PERM = true, AFTER_DRAIN = false;
    bf16_t* O; int ldc;
    __device__ __forceinline__ void operator()(const f32x4 (&acc)[2][2][4][2], const Unit& u, int wr, int wc, int fr_, int fq_) const {
        int fr = fr_, fq = fq_; asm volatile("" : "+v"(fr), "+v"(fq));
        const int row0 = u.pm * BM + wr * 64 + fr; const int col0 = u.pn * BM + wc * 32 + 8 * fq;
#pragma unroll
        for (int ai = 0; ai < 2; ++ai)
#pragma unroll
            for (int m = 0; m < 4; ++m) { bf16_t* rowp = O + (size_t)(row0 + ai * HALF + m * 16) * ldc + col0;
#pragma unroll
                for (int bj = 0; bj < 2; ++bj) { const f32x4 v0 = acc[ai][bj][m][0], v1 = acc[ai][bj][m][1];
                    u32x4 w; w.x = cvt_pk_bf16(v0[0], v0[1]); w.y = cvt_pk_bf16(v0[2], v0[3]); w.z = cvt_pk_bf16(v1[0], v1[1]); w.w = cvt_pk_bf16(v1[2], v1[3]);
                    st16_wt(rowp + bj * HALF, w); } }
    }
};
__device__ __forceinline__ float silu_f(float a) { return a * __builtin_amdgcn_rcpf(1.0f + __builtin_amdgcn_exp2f(-1.4426950408889634f * a)); }
struct EpiSwiGLU {
    static constexpr bool PERM = true, AFTER_DRAIN = false;
    bf16_t* O; int ldc;
    __device__ __forceinline__ void operator()(const f32x4 (&acc)[2][2][4][2], const Unit& u, int wr, int wc, int fr_, int fq_) const {
        int fr = fr_, fq = fq_; asm volatile("" : "+v"(fr), "+v"(fq));
        const int row0 = u.pm * BM + wr * 64 + fr; const int col0 = u.pn * HALF + wc * 32 + 8 * fq;
#pragma unroll
        for (int ai = 0; ai < 2; ++ai)
#pragma unroll
            for (int m = 0; m < 4; ++m) { bf16_t* rowp = O + (size_t)(row0 + ai * HALF + m * 16) * ldc + col0;
                const f32x4 a0 = acc[ai][0][m][0], a1 = acc[ai][0][m][1], g0 = acc[ai][1][m][0], g1 = acc[ai][1][m][1];
                u32x4 w;
                w.x = cvt_pk_bf16(silu_f(a0[0]) * g0[0], silu_f(a0[1]) * g0[1]); w.y = cvt_pk_bf16(silu_f(a0[2]) * g0[2], silu_f(a0[3]) * g0[3]);
                w.z = cvt_pk_bf16(silu_f(a1[0]) * g1[0], silu_f(a1[1]) * g1[1]); w.w = cvt_pk_bf16(silu_f(a1[2]) * g1[2], silu_f(a1[3]) * g1[3]);
                st16_wt(rowp, w); }
    }
};
struct EpiRes {
    static constexpr bool PERM = true, AFTER_DRAIN = false;
    const float* xin_lo; const float* xin_hi;
    bf16_t* xb; const float* gate;
    __device__ __forceinline__ void operator()(const f32x4 (&acc)[2][2][4][2], const Unit& u, int wr, int wc, int fr_, int fq_) const {
        int fr = fr_, fq = fq_; asm volatile("" : "+v"(fr), "+v"(fq));
        const int rt = u.pm * BM; const int cond = rt < 8192 ? 0 : 1 + ((rt - 8192) >> 10);
        const int col0 = u.pn * BM + wc * 32 + 8 * fq; const float* g = gate + cond * 6144 + col0;
        bf16_t* dst = xb + (size_t)rt * 1024 + col0;
        f32x4 gv[2][2];
#pragma unroll
        for (int bj = 0; bj < 2; ++bj)
#pragma unroll
            for (int n = 0; n < 2; ++n) gv[bj][n] = *(const f32x4*)(g + bj * HALF + 4 * n);
        if (xin_lo != nullptr) {
            const float* src = (rt < 8192 ? xin_lo + (size_t)rt * 1024 : xin_hi + (size_t)(rt - 8192) * 1024) + col0;
#pragma unroll
            for (int am = 0; am < 8; ++am) {
                const int ai = am >> 2, m = am & 3; const size_t off = (size_t)(ai * HALF + wr * 64 + m * 16 + fr) * 1024;
                f32x4 xv[2][2];
#pragma unroll
                for (int bj = 0; bj < 2; ++bj)
#pragma unroll
                    for (int n = 0; n < 2; ++n) xv[bj][n] = *(const f32x4*)(src + off + bj * HALF + 4 * n);
#pragma unroll
                for (int bj = 0; bj < 2; ++bj) { const f32x4 v0 = xv[bj][0] + gv[bj][0] * acc[ai][bj][m][0], v1 = xv[bj][1] + gv[bj][1] * acc[ai][bj][m][1];
                    u32x4 w; w.x = cvt_pk_bf16(v0[0], v0[1]); w.y = cvt_pk_bf16(v0[2], v0[3]); w.z = cvt_pk_bf16(v1[0], v1[1]); w.w = cvt_pk_bf16(v1[2], v1[3]);
                    *(u32x4*)(dst + off + bj * HALF) = w; }
            }
        } else {
#pragma unroll
            for (int ai = 0; ai < 2; ++ai) {
                u32x4 xv[4][2];
#pragma unroll
                for (int m = 0; m < 4; ++m) { const size_t off = (size_t)(ai * HALF + wr * 64 + m * 16 + fr) * 1024;
#pragma unroll
                    for (int bj = 0; bj < 2; ++bj) xv[m][bj] = *(const u32x4*)(dst + off + bj * HALF); }
#pragma unroll
                for (int m = 0; m < 4; ++m) { const size_t off = (size_t)(ai * HALF + wr * 64 + m * 16 + fr) * 1024;
#pragma unroll
                    for (int bj = 0; bj < 2; ++bj) { const u32x4 x = xv[m][bj];
                        const f32x4 x0 = (f32x4){__uint_as_float(x.x << 16), __uint_as_float(x.x & 0xffff0000u), __uint_as_float(x.y << 16), __uint_as_float(x.y & 0xffff0000u)};
                        const f32x4 x1 = (f32x4){__uint_as_float(x.z << 16), __uint_as_float(x.z & 0xffff0000u), __uint_as_float(x.w << 16), __uint_as_float(x.w & 0xffff0000u)};
                        const f32x4 v0 = x0 + gv[bj][0] * acc[ai][bj][m][0], v1 = x1 + gv[bj][1] * acc[ai][bj][m][1];
                        u32x4 w; w.x = cvt_pk_bf16(v0[0], v0[1]); w.y = cvt_pk_bf16(v0[2], v0[3]); w.z = cvt_pk_bf16(v1[0], v1[1]); w.w = cvt_pk_bf16(v1[2], v1[3]);
                        *(u32x4*)(dst + off + bj * HALF) = w; } }
            }
        }
    }
};

template <class Epi, class Sched, bool ALIGN_EPI = false, bool SP2 = false>
__device__ __forceinline__ void gemm_phase(LAS unsigned char* lds, const Gemm g, const Sched& S, const Epi& E) {
    int tid_ = threadIdx.x; asm volatile("" : "+v"(tid_));
    const int tid = tid_, wid = __builtin_amdgcn_readfirstlane(tid >> 6), lane = tid & 63, wr = wid >> 2, wc = wid & 3, fr = lane & 15, fq = lane >> 4;
    const int K = g.K, nt = K / BK;
    unsigned voffA[2], voffB[2];
#pragma unroll
    for (int i = 0; i < 2; ++i) { int R, C; stage_rc(tid * 16 + i * 8192, R, C); const int Rb = Epi::PERM ? ((R & ~31) + perm32(R & 31)) : R;
        voffA[i] = (unsigned)(R * K + C) * 2u; voffB[i] = (unsigned)(Rb * K + C) * 2u; }
    const size_t kstep = (size_t)(BK * 2);
    const size_t hstep = (size_t)HALF * K * 2;
    const size_t tstep = 2 * hstep;
    const unsigned ldsw = (unsigned)wid * 1024u;
    const int aoff = lds_byte(wr * 64 + fr, fq * 8), boff = lds_byte(wc * 32 + fr, fq * 8);
#define PG8_SA(b, h) (((b) * 2 + (h)) * HTB)
#define PG8_SB(b, h) ((4 + (b) * 2 + (h)) * HTB)
#define PG8_STAGE(bufoff, gbase, voff) do { _Pragma("unroll") for (int _i = 0; _i < 2; ++_i) \
        __builtin_amdgcn_global_load_lds((const unsigned*)((const char*)(gbase) + (voff)[_i]), (LAS unsigned*)(lds + (bufoff) + ldsw + _i * 8192), 16, 0, 0); } while (0)
#define PG8_LDA(dst, b, h) do { _Pragma("unroll") for (int m = 0; m < 4; ++m) _Pragma("unroll") for (int k = 0; k < 2; ++k) dst[m][k] = *(const LAS bf16x8*)(lds + PG8_SA(b, h) + aoff + m * 2048 + k * 1024); } while (0)
#define PG8_LDB(dst, b, h) do { _Pragma("unroll") for (int n = 0; n < 2; ++n) _Pragma("unroll") for (int k = 0; k < 2; ++k) dst[n][k] = *(const LAS bf16x8*)(lds + PG8_SB(b, h) + boff + n * 2048 + k * 1024); } while (0)
#define PG8_MMA(ai, bj, At, Bt) do { __builtin_amdgcn_s_setprio(1); _Pragma("unroll") for (int m = 0; m < 4; ++m) _Pragma("unroll") for (int n = 0; n < 2; ++n) _Pragma("unroll") for (int k = 0; k < 2; ++k) \
        acc[ai][bj][m][n] = __builtin_amdgcn_mfma_f32_16x16x32_bf16(Bt[n][k], At[m][k], acc[ai][bj][m][n], 0, 0, 0); __builtin_amdgcn_s_setprio(0); } while (0)
#define PG8_WAIT_V(n) asm volatile("s_waitcnt vmcnt(" #n ")" ::: "memory")
#define PG8_WAIT_L(n) asm volatile("s_waitcnt lgkmcnt(" #n ")" ::: "memory")
#define PG8_BAR __builtin_amdgcn_s_barrier()
#define PG8_SCHED __builtin_amdgcn_sched_barrier(0)
    Unit cur, nxt; int ui = 0;
    if (!S.next(0, cur)) return;
    f32x4 acc[2][2][4][2];
#pragma unroll
    for (int a = 0; a < 2; ++a)
#pragma unroll
        for (int b = 0; b < 2; ++b)
#pragma unroll
            for (int m = 0; m < 4; ++m)
#pragma unroll
                for (int n = 0; n < 2; ++n) acc[a][b][m][n] = (f32x4){0.f, 0.f, 0.f, 0.f};
    bf16x8 At[4][2], B0[2][2], B1[2][2];
    const char* cA = (const char*)g.A + (size_t)cur.pm * tstep; const char* cB = (const char*)g.Bt + (size_t)cur.pn * tstep;
    S.a_ready(cur);
    if constexpr (SP2) {
        PG8_STAGE(PG8_SB(0, 0), cB, voffB); PG8_STAGE(PG8_SB(0, 1), cB + hstep, voffB); PG8_STAGE(PG8_SA(0, 0), cA, voffA); PG8_STAGE(PG8_SA(0, 1), cA + hstep, voffA);
        if (wr == 1) PG8_BAR;
        PG8_WAIT_V(2); PG8_BAR;
        PG8_STAGE(PG8_SB(1, 0), cB + kstep, voffB); PG8_STAGE(PG8_SA(1, 0), cA + kstep, voffA); PG8_STAGE(PG8_SB(1, 1), cB + hstep + kstep, voffB);
        PG8_WAIT_V(6); PG8_BAR;
    } else {
        PG8_STAGE(PG8_SB(0, 0), cB, voffB); PG8_STAGE(PG8_SA(0, 0), cA, voffA); PG8_STAGE(PG8_SB(0, 1), cB + hstep, voffB); PG8_STAGE(PG8_SA(0, 1), cA + hstep, voffA);
        if (wr == 1) PG8_BAR;
        PG8_WAIT_V(4); PG8_BAR;
        PG8_STAGE(PG8_SB(1, 0), cB + kstep, voffB); PG8_STAGE(PG8_SA(1, 0), cA + kstep, voffA); PG8_STAGE(PG8_SB(1, 1), cB + hstep + kstep, voffB);
        PG8_WAIT_V(6); PG8_BAR;
    }
    for (;;) {
        const bool has_next = S.next(ui + 1, nxt);
        const char* nA = has_next ? (const char*)g.A + (size_t)nxt.pm * tstep : cA; const char* nB = has_next ? (const char*)g.Bt + (size_t)nxt.pn * tstep : cB;
        for (int t = 0; t < nt; t += 2) {
            const bool last = (t == nt - 2);
            const char* a1 = cA + (size_t)(t + 1) * kstep;
            const char* a2 = last ? nA : cA + (size_t)(t + 2) * kstep; const char* b2 = last ? nB : cB + (size_t)(t + 2) * kstep;
            const char* a3 = a2 + kstep; const char* b3 = b2 + kstep;
            if (last && has_next) S.a_ready(nxt);
            if constexpr (SP2) {
            PG8_LDB(B0, 0, 0); PG8_LDB(B1, 0, 1); PG8_SCHED; PG8_LDA(At, 0, 0); PG8_STAGE(PG8_SA(1, 1), a1 + hstep, voffA);
            PG8_WAIT_V(8); PG8_WAIT_L(0); PG8_BAR; PG8_MMA(0, 0, At, B0); PG8_MMA(0, 1, At, B1); PG8_BAR; PG8_SCHED;
            PG8_LDA(At, 0, 1); PG8_STAGE(PG8_SB(0, 0), b2, voffB); PG8_STAGE(PG8_SB(0, 1), b2 + hstep, voffB); PG8_STAGE(PG8_SA(0, 0), a2, voffA);
            PG8_WAIT_V(8); PG8_WAIT_L(0); PG8_BAR; PG8_MMA(1, 0, At, B0); PG8_MMA(1, 1, At, B1); PG8_BAR; PG8_SCHED;
            PG8_LDB(B0, 1, 0); PG8_LDB(B1, 1, 1); PG8_SCHED; PG8_LDA(At, 1, 0); PG8_STAGE(PG8_SA(0, 1), a2 + hstep, voffA);
            PG8_WAIT_V(8); PG8_WAIT_L(0); PG8_BAR; PG8_MMA(0, 0, At, B0); PG8_MMA(0, 1, At, B1); PG8_BAR; PG8_SCHED;
            PG8_LDA(At, 1, 1); PG8_STAGE(PG8_SB(1, 0), b3, voffB); PG8_STAGE(PG8_SB(1, 1), b3 + hstep, voffB); PG8_STAGE(PG8_SA(1, 0), a3, voffA);
            PG8_WAIT_V(8); PG8_WAIT_L(0); PG8_BAR; PG8_MMA(1, 0, At, B0); PG8_MMA(1, 1, At, B1); PG8_BAR; PG8_SCHED;
            } else {
            PG8_LDB(B0, 0, 0); PG8_SCHED; PG8_LDA(At, 0, 0); PG8_STAGE(PG8_SA(1, 1), a1 + hstep, voffA);
            PG8_WAIT_L(8); PG8_BAR; PG8_WAIT_L(0); PG8_MMA(0, 0, At, B0); PG8_BAR; PG8_SCHED;
            PG8_LDB(B1, 0, 1); PG8_STAGE(PG8_SB(0, 0), b2, voffB);
            PG8_BAR; PG8_WAIT_L(0); PG8_MMA(0, 1, At, B1); PG8_BAR;
            PG8_LDA(At, 0, 1); PG8_STAGE(PG8_SA(0, 0), a2, voffA);
            PG8_BAR; PG8_WAIT_L(0); PG8_MMA(1, 0, At, B0); PG8_BAR; PG8_SCHED;
            PG8_STAGE(PG8_SB(0, 1), b2 + hstep, voffB);
            PG8_WAIT_V(6); PG8_BAR; PG8_MMA(1, 1, At, B1); PG8_BAR;
            PG8_LDB(B0, 1, 0); PG8_SCHED; PG8_LDA(At, 1, 0); PG8_STAGE(PG8_SA(0, 1), a2 + hstep, voffA);
            PG8_WAIT_L(8); PG8_BAR; PG8_WAIT_L(0); PG8_MMA(0, 0, At, B0); PG8_BAR; PG8_SCHED;
            PG8_LDB(B1, 1, 1); PG8_STAGE(PG8_SB(1, 0), b3, voffB);
            PG8_BAR; PG8_WAIT_L(0); PG8_MMA(0, 1, At, B1); PG8_BAR;
            PG8_LDA(At, 1, 1); PG8_STAGE(PG8_SA(1, 0), a3, voffA);
            PG8_BAR; PG8_WAIT_L(0); PG8_MMA(1, 0, At, B0); PG8_BAR; PG8_SCHED;
            PG8_STAGE(PG8_SB(1, 1), b3 + hstep, voffB);
            PG8_WAIT_V(6); PG8_BAR; PG8_MMA(1, 1, At, B1); PG8_BAR;
            }
        }
        if constexpr (ALIGN_EPI) { if (wr == 0) PG8_BAR; }
        if constexpr (!Epi::AFTER_DRAIN) { E(acc, cur, wr, wc, fr, fq); S.done(cur); }
        if (!has_next) break;
#pragma unroll
        for (int a = 0; a < 2; ++a)
#pragma unroll
            for (int b = 0; b < 2; ++b)
#pragma unroll
                for (int m = 0; m < 4; ++m)
#pragma unroll
                    for (int n = 0; n < 2; ++n) acc[a][b][m][n] = (f32x4){0.f, 0.f, 0.f, 0.f};
        cur = nxt; cA = nA; cB = nB; ++ui;
        if constexpr (ALIGN_EPI) { if (wr == 1) PG8_BAR; }
    }
    PG8_WAIT_V(0);
    if constexpr (!ALIGN_EPI) { if (wr == 0) PG8_BAR; }
    PG8_BAR;
#undef PG8_SA
#undef PG8_SB
#undef PG8_STAGE
#undef PG8_LDA
#undef PG8_LDB
#undef PG8_MMA
#undef PG8_WAIT_V
#undef PG8_WAIT_L
#undef PG8_BAR
#undef PG8_SCHED
}
}

constexpr int NWAVES = 8, NTHR = 512;
constexpr int DM = 1024, NTOK = 16384, NCTXR = 8192, DEPTH = 4;
constexpr int UP = 2816;
constexpr int DFF = 2816;
constexpr int U_XBC = 512, U_DT = 1280, U_RQ = 1296, U_RK = 1552, U_RV = 1808, U_RG = 2064, U_MQ = 2320, U_MKV = 2576, U_MKR = 2704;
constexpr int KVROWS = 8192 + 8 * 1536;
constexpr float EPS = 1e-6f;
constexpr int LDS_BYTES = 147456;

constexpr size_t MiB = 1u << 20;
constexpr size_t WS_MOD = 1 * MiB, WS_ROPE = 2 * MiB, WS_DT = 3 * MiB, WS_LA = 4 * MiB, WS_KR = 5 * MiB, WS_CKV = 7 * MiB, WS_QC = 12 * MiB,
                 WS_Q = 20 * MiB, WS_KV = 36 * MiB, WS_XBC = 56 * MiB, WS_YSSD = 80 * MiB, WS_YRET = 112 * MiB, WS_ABUF = 128 * MiB, WS_U = 160 * MiB, WS_W = 248 * MiB;
constexpr size_t WL_IN = 0, WL_OUT = WL_IN + (size_t)UP * 1024, WL_W1 = WL_OUT + 1024 * 1024, WL_W2 = WL_W1 + (size_t)5632 * 1024, WL_UQ = WL_W2 + (size_t)1024 * 2816,
                 WL_UKV = WL_UQ + 512 * 256, WL_TOTAL = WL_UKV + 512 * 128;
constexpr size_t WS_XB = 348 * MiB;
constexpr size_t WS_END = 380 * MiB;
static_assert(WS_W + 4 * WL_TOTAL * 2 <= WS_XB, "d_ws map");

constexpr size_t O_YP = 0, O_YS = 8388608, O_SSD = 16777216, O_RET = 25165824, O_CKV = 29360128, O_KR = 33554432;

struct Args { const float* in[29]; float* out; unsigned char* ws; int ph_lo, ph_hi; };

constexpr int PT_OFF = 140288;
__device__ __forceinline__ int fresh_tid() { int t = threadIdx.x; asm volatile("" : "+v"(t)); return t; }
#define TIDS const int tid = fresh_tid(), lane = tid & 63, wave = __builtin_amdgcn_readfirstlane(tid >> 6)
struct Ctx {
    LAS unsigned char* lds; int G, bid; float* out; unsigned char* ws;
    __device__ __forceinline__ const float* in(int k) const { const u32x2 v = *(const LAS u32x2*)(lds + PT_OFF + 8 * k);
        const unsigned lo = __builtin_amdgcn_readfirstlane(v.x), hi = __builtin_amdgcn_readfirstlane(v.y); return (const float*)(const GAS float*)(((unsigned long long)hi << 32) | lo); }
    __device__ __forceinline__ float* mod() const { return (float*)(ws + WS_MOD); }
    __device__ __forceinline__ float* ropec() const { return (float*)(ws + WS_ROPE); }
    __device__ __forceinline__ float* ropes() const { return (float*)(ws + WS_ROPE) + 1024 * 32; }
    __device__ __forceinline__ float* dtb() const { return (float*)(ws + WS_DT); }
    __device__ __forceinline__ float* lab() const { return (float*)(ws + WS_LA); }
    __device__ __forceinline__ bf16_t* krall() const { return (bf16_t*)(ws + WS_KR); }
    __device__ __forceinline__ bf16_t* ckvall() const { return (bf16_t*)(ws + WS_CKV); }
    __device__ __forceinline__ bf16_t* qc() const { return (bf16_t*)(ws + WS_QC); }
    __device__ __forceinline__ bf16_t* qb() const { return (bf16_t*)(ws + WS_Q); }
    __device__ __forceinline__ bf16_t* kvb() const { return (bf16_t*)(ws + WS_KV); }
    __device__ __forceinline__ bf16_t* xbc() const { return (bf16_t*)(ws + WS_XBC); }
    __device__ __forceinline__ bf16_t* yssd() const { return (bf16_t*)(ws + WS_YSSD); }
    __device__ __forceinline__ bf16_t* yret() const { return (bf16_t*)(ws + WS_YRET); }
    __device__ __forceinline__ bf16_t* abuf() const { return (bf16_t*)(ws + WS_ABUF); }
    __device__ __forceinline__ bf16_t* ub() const { return (bf16_t*)(ws + WS_U); }
    __device__ __forceinline__ bf16_t* wts() const { return (bf16_t*)(ws + WS_W); }
    __device__ __forceinline__ bf16_t* xb() const { return (bf16_t*)(ws + WS_XB); }
};

__device__ __forceinline__ float bf2f(unsigned v) { return __uint_as_float(v << 16); }
__device__ __forceinline__ float bflo(unsigned w) { return __uint_as_float(w << 16); }
__device__ __forceinline__ float bfhi(unsigned w) { return __uint_as_float(w & 0xffff0000u); }
__device__ __forceinline__ unsigned pk2(float lo, float hi) { return pg8::cvt_pk_bf16(lo, hi); }
template <int CTRL> __device__ __forceinline__ float dppf(float v) { return __builtin_bit_cast(float, __builtin_amdgcn_update_dpp(0, __builtin_bit_cast(int, v), CTRL, 0xf, 0xf, false)); }
__device__ __forceinline__ float row16_sum(float v) { v += dppf<0x128>(v); v += dppf<0x124>(v); v += dppf<0x122>(v); v += dppf<0x121>(v); return v; }
__device__ __forceinline__ float rlane(float v, int l) { return __builtin_bit_cast(float, __builtin_amdgcn_readlane(__builtin_bit_cast(int, v), l)); }
__device__ __forceinline__ float wave_sum(float v) { v = row16_sum(v); return (rlane(v, 0) + rlane(v, 16)) + (rlane(v, 32) + rlane(v, 48)); }
__device__ __forceinline__ int cond_of_row(int r) { return r < NCTXR ? 0 : 1 + ((r - NCTXR) >> 10); }
__device__ __forceinline__ int xcd_tile(int bid) { return (bid & 7) * 32 + (bid >> 3); }
__device__ __forceinline__ int xcd_row(int v, int G) { if (G != 256) return v; const int bid = (v & 2047) >> 3; return xcd_tile(bid) * 64 + (v >> 11) * 8 + (v & 7); }


template <int MODE>
__device__ __forceinline__ void transpose_item(const float* W, int K, int N, bf16_t* WT, LAS float* scr, int item, int lane, int nblk) {
    const int kb = item / nblk, nb = item % nblk, k0 = 64 * kb, n0 = 32 * nb;
    const int ks = lane >> 3, ns = lane & 7, nn = n0 + 4 * ns; const bool ok = nn < N;
    f32x4 v[8];
#pragma unroll
    for (int i = 0; i < 8; ++i) v[i] = ok ? __builtin_nontemporal_load((const f32x4*)(W + (size_t)(k0 + i * 8 + ks) * N + nn)) : (f32x4){0.f, 0.f, 0.f, 0.f};
#pragma unroll
    for (int i = 0; i < 8; ++i) { LAS float* d = scr + (i * 8 + ks) * 33 + 4 * ns; d[0] = v[i].x; d[1] = v[i].y; d[2] = v[i].z; d[3] = v[i].w; }
    asm volatile("s_waitcnt lgkmcnt(0)" ::: "memory");
    const int c = lane & 7;
#pragma unroll
    for (int j = 0; j < 4; ++j) { const int nl = (lane >> 3) + 8 * j; const int n = n0 + nl; const LAS float* s = scr + (8 * c) * 33 + nl;
        int row = n;
        if (MODE == 1) { const int jj = n < 2816 ? n : n - 2816; row = 256 * (jj >> 7) + (jj & 127) + (n < 2816 ? 0 : 128); }
        u32x4 o; o.x = pk2(s[0 * 33], s[1 * 33]); o.y = pk2(s[2 * 33], s[3 * 33]); o.z = pk2(s[4 * 33], s[5 * 33]); o.w = pk2(s[6 * 33], s[7 * 33]);
        *(u32x4*)(WT + (size_t)row * K + k0 + 8 * c) = o; }
    asm volatile("s_waitcnt lgkmcnt(0)" ::: "memory");
}

__device__ __forceinline__ void convert_weights(Ctx& C, int l, int widx, int nw, int wave, int lane, int which = 0) {
    LAS float* scr = (LAS float*)(C.lds + wave * 8448);
    constexpr int I_IN = 16 * 88, I_OUT = 16 * 32, I_W1 = 16 * 176, I_W2 = 44 * 32, I_UQ = 4 * 16, I_UKV = 2 * 16, I_L = I_IN + I_OUT + I_W1 + I_W2 + I_UQ + I_UKV;
    bf16_t* wl = C.wts() + (size_t)l * WL_TOTAL;
    for (int it = widx; it < I_L; it += nw) {
        int r = it;
        { const bool late = r >= I_IN && r < I_IN + I_OUT + I_W1 + I_W2; if ((which == 1 && late) || (which == 2 && !late)) continue; }
        if (r < I_IN) { transpose_item<0>(C.in(11) + (size_t)l * 1024 * 2736, 1024, 2736, wl + WL_IN, scr, r, lane, 88); continue; } r -= I_IN;
        if (r < I_OUT) { transpose_item<0>(C.in(24) + (size_t)l * 1024 * 1024, 1024, 1024, wl + WL_OUT, scr, r, lane, 32); continue; } r -= I_OUT;
        if (r < I_W1) { transpose_item<1>(C.in(26) + (size_t)l * 1024 * 5632, 1024, 5632, wl + WL_W1, scr, r, lane, 176); continue; } r -= I_W1;
        if (r < I_W2) { transpose_item<0>(C.in(27) + (size_t)l * 2816 * 1024, 2816, 1024, wl + WL_W2, scr, r, lane, 32); continue; } r -= I_W2;
        if (r < I_UQ) { transpose_item<0>(C.in(21) + (size_t)l * 256 * 384, 256, 384, wl + WL_UQ, scr, r, lane, 16); continue; } r -= I_UQ;
        transpose_item<0>(C.in(23) + (size_t)l * 128 * 512, 128, 512, wl + WL_UKV, scr, r, lane, 16);
    }
}

__device__ __forceinline__ void phase_prologue(Ctx& C) {
    TIDS;
    for (int i = C.bid * NTHR + tid; i < 1024 * 32; i += C.G * NTHR) {
        const int t = i >> 5, d = i & 31, i8 = d & 7; const float pos = (float)((d < 16) ? (t >> 6) : (t & 63));
        const float inv = exp2f(-(float)i8 * 0.125f * 13.287712379549449f);
        const float ang = pos * inv;
        const float k = rintf(ang * 0.15915494309189535f);
        float rr = fmaf(-k, 6.28125f, ang); rr = fmaf(-k, 1.9353071795864769e-3f, rr);
        C.ropec()[i] = cosf(rr); C.ropes()[i] = sinf(rr);
    }
    if (C.bid < 192) {
        LAS float* sc = (LAS float*)(C.lds);
        LAS float* red = (LAS float*)(C.lds + 36 * 1024);
        const float* cctx = C.in(7); const float* cc = C.in(2);
        for (int i = tid; i < 9 * 1024; i += NTHR) { const int cnd = i >> 10, k = i & 1023; const float v = cnd == 0 ? cctx[k] : cc[(cnd - 1) * 1024 + k]; sc[i] = v / (1.0f + __expf(-v)); }
        __syncthreads();
        for (int task = C.bid; task < 192; task += C.G) {
            const int l = task / 48, col0 = (task % 48) * 128;
            const float* W = C.in(8) + (size_t)l * 1024 * 6144 + col0 + 2 * lane + (size_t)(wave * 128) * 6144;
            f32x2 a[9];
#pragma unroll
            for (int q = 0; q < 9; ++q) a[q] = (f32x2){0.f, 0.f};
            for (int k8 = 0; k8 < 128; k8 += 8) {
                f32x2 w[8];
#pragma unroll
                for (int e = 0; e < 8; ++e) w[e] = __builtin_nontemporal_load((const f32x2*)(W + (size_t)(k8 + e) * 6144));
#pragma unroll
                for (int q = 0; q < 9; ++q) { const f32x4 s0 = *(const LAS f32x4*)(sc + q * 1024 + wave * 128 + k8), s1 = *(const LAS f32x4*)(sc + q * 1024 + wave * 128 + k8 + 4);
                    a[q] += w[0] * s0.x; a[q] += w[1] * s0.y; a[q] += w[2] * s0.z; a[q] += w[3] * s0.w; a[q] += w[4] * s1.x; a[q] += w[5] * s1.y; a[q] += w[6] * s1.z; a[q] += w[7] * s1.w; }
            }
#pragma unroll
            for (int q = 0; q < 9; ++q) *(LAS f32x2*)(red + (wave * 9 + q) * 128 + 2 * lane) = a[q];
            __syncthreads();
            const float* bada = C.in(9);
            for (int o = tid; o < 9 * 128; o += NTHR) { const int q = o >> 7, c = o & 127; float sum = 0.f;
#pragma unroll
                for (int z = 0; z < 8; ++z) sum += red[(z * 9 + q) * 128 + c];
                C.mod()[((size_t)l * 9 + q) * 6144 + col0 + c] = sum + bada[(size_t)l * 6144 + col0 + c]; }
            __syncthreads();
        }
    }
    __syncthreads();
    convert_weights(C, 0, C.bid * NWAVES + wave, C.G * NWAVES, wave, lane, 1);
}

template <int MODE>
__device__ __forceinline__ void phase_norm(Ctx& C, const float* xlo, const float* xhi, const float* w, const float* modl, int sh_off, int sc_off) {
    TIDS;
    const int gw = C.bid * NWAVES + wave, NGW = C.G * NWAVES;
    f32x4 wv[4];
#pragma unroll
    for (int j = 0; j < 4; ++j) wv[j] = *(const f32x4*)(w + 4 * lane + 256 * j);
    for (int r0 = gw; r0 < NTOK; r0 += 2 * NGW) {
        f32x4 v[2][4]; int rr[2];
#pragma unroll
        for (int q = 0; q < 2; ++q) { const int r = xcd_row(r0 + q * NGW < NTOK ? r0 + q * NGW : r0, C.G); rr[q] = r;
            const float* xr = r < NCTXR ? xlo + (size_t)r * DM : xhi + (size_t)(r - NCTXR) * DM;
#pragma unroll
            for (int j = 0; j < 4; ++j) v[q][j] = *(const f32x4*)(xr + 4 * lane + 256 * j); }
#pragma unroll
        for (int q = 0; q < 2; ++q) { const int r = rr[q]; float s = 0.f;
#pragma unroll
            for (int j = 0; j < 4; ++j) s += (v[q][j].x * v[q][j].x + v[q][j].y * v[q][j].y) + (v[q][j].z * v[q][j].z + v[q][j].w * v[q][j].w);
            const float rstd = rsqrtf(wave_sum(s) * (1.f / DM) + EPS);
            if (MODE == 0) {
                const float* m = modl + cond_of_row(r) * 6144;
#pragma unroll
                for (int j = 0; j < 4; ++j) { const int c = 4 * lane + 256 * j; const f32x4 scv = *(const f32x4*)(m + sc_off + c), shv = *(const f32x4*)(m + sh_off + c);
                    const f32x4 h = v[q][j] * rstd * wv[j] * (scv + 1.0f) + shv;
                    u32x2 o; o.x = pk2(h.x, h.y); o.y = pk2(h.z, h.w); *(u32x2*)(C.abuf() + (size_t)r * DM + c) = o; }
            } else {
#pragma unroll
                for (int j = 0; j < 4; ++j) { const int c = 4 * lane + 256 * j; *(f32x4*)(C.out + (size_t)r * DM + c) = v[q][j] * rstd * wv[j]; }
            }
        }
    }
}

template <int MODE>
__device__ __forceinline__ void phase_norm_b(Ctx& C, const float* w, const float* modl, int sh_off, int sc_off) {
    TIDS;
    const int gw = C.bid * NWAVES + wave, NGW = C.G * NWAVES;
    f32x4 wv[2][2];
#pragma unroll
    for (int j = 0; j < 2; ++j) { wv[j][0] = *(const f32x4*)(w + 8 * lane + 512 * j); wv[j][1] = *(const f32x4*)(w + 8 * lane + 512 * j + 4); }
    for (int r0 = gw; r0 < NTOK; r0 += 4 * NGW) {
        u32x4 raw[4][2]; int rr[4];
#pragma unroll
        for (int q = 0; q < 4; ++q) { const int r = xcd_row(r0 + q * NGW < NTOK ? r0 + q * NGW : r0, C.G); rr[q] = r;
#pragma unroll
            for (int j = 0; j < 2; ++j) raw[q][j] = *(const u32x4*)(C.xb() + (size_t)r * DM + 8 * lane + 512 * j); }
#pragma unroll
        for (int q = 0; q < 4; ++q) { const int r = rr[q]; f32x4 v[2][2]; float s = 0.f;
#pragma unroll
            for (int j = 0; j < 2; ++j) { const u32x4 x = raw[q][j]; v[j][0] = (f32x4){bflo(x.x), bfhi(x.x), bflo(x.y), bfhi(x.y)}; v[j][1] = (f32x4){bflo(x.z), bfhi(x.z), bflo(x.w), bfhi(x.w)};
#pragma unroll
                for (int hh = 0; hh < 2; ++hh) s += (v[j][hh].x * v[j][hh].x + v[j][hh].y * v[j][hh].y) + (v[j][hh].z * v[j][hh].z + v[j][hh].w * v[j][hh].w); }
            const float rstd = rsqrtf(wave_sum(s) * (1.f / DM) + EPS);
            if (MODE == 0) {
                const float* m = modl + cond_of_row(r) * 6144;
#pragma unroll
                for (int j = 0; j < 2; ++j) { const int c = 8 * lane + 512 * j; f32x4 h[2];
#pragma unroll
                    for (int hh = 0; hh < 2; ++hh) { const f32x4 scv = *(const f32x4*)(m + sc_off + c + 4 * hh), shv = *(const f32x4*)(m + sh_off + c + 4 * hh); h[hh] = v[j][hh] * rstd * wv[j][hh] * (scv + 1.0f) + shv; }
                    u32x4 o; o.x = pk2(h[0].x, h[0].y); o.y = pk2(h[0].z, h[0].w); o.z = pk2(h[1].x, h[1].y); o.w = pk2(h[1].z, h[1].w); *(u32x4*)(C.abuf() + (size_t)r * DM + c) = o; }
            } else {
#pragma unroll
                for (int j = 0; j < 2; ++j) { const int c = 8 * lane + 512 * j;
#pragma unroll
                    for (int hh = 0; hh < 2; ++hh) *(f32x4*)(C.out + (size_t)r * DM + c + 4 * hh) = v[j][hh] * rstd * wv[j][hh]; }
            }
        }
    }
}

#define MFMA16P(x, y, c) __builtin_amdgcn_mfma_f32_16x16x32_bf16((x), (y), (c), 0, 0, 0)
constexpr int PP_QC = 0, PP_CKV = 33792;
__device__ __forceinline__ void phase_prep(Ctx& C, int layer) {
    TIDS; const int fr = lane & 15, fq = lane >> 4;
    LAS bf16_t* sQC = (LAS bf16_t*)(C.lds + PP_QC); LAS bf16_t* sCKV = (LAS bf16_t*)(C.lds + PP_CKV);
    const float* cw = C.in(12) + (size_t)layer * 5 * 768; const float* cb = C.in(13) + (size_t)layer * 768;
    const f32x4 qnw = *(const f32x4*)(C.in(20) + layer * 256 + 4 * lane); const f32x2 kvnw = *(const f32x2*)(C.in(22) + layer * 128 + 2 * lane);
    const float dtbias = C.in(14)[layer * 16 + (lane & 15)], aexp = __expf(C.in(15)[layer * 16 + (lane & 15)]);
    const bf16_t* wl = C.wts() + (size_t)layer * WL_TOTAL;
    for (int tile_ = C.bid; tile_ < NTOK / 64; tile_ += C.G) { const int tile = C.G == 256 ? xcd_tile(tile_) : tile_;
        __syncthreads();
        f32x2 cv[2], ck[2];
#pragma unroll
        for (int q = 0; q < 2; ++q) { const int idx = 16 * tile + 2 * wave + q, b = idx >> 9, sx = idx & 511;
            cv[q] = *(const f32x2*)(C.in(5) + (((size_t)b * DEPTH + layer) * 512 + sx) * 128 + 2 * lane);
            ck[q] = *(const f32x2*)(C.in(6) + (((size_t)b * DEPTH + layer) * 512 + sx) * 32 + 2 * (lane & 15)); }
        const int r0 = tile * 64 + wave * 8; const bool ctx = r0 < NCTXR; const int b = ctx ? (r0 >> 8) : ((r0 - NCTXR) >> 10), t0 = ctx ? (r0 & 255) : ((r0 - NCTXR) & 1023), L = ctx ? 256 : 1024;
        const bf16_t* u0 = C.ub() + (size_t)r0 * UP;
        unsigned rdt[8]; u32x2 rq[8]; unsigned rkv[8]; unsigned rkr[8];
#pragma unroll
        for (int j = 0; j < 8; ++j) { const bf16_t* ur = u0 + (size_t)j * UP; rdt[j] = ur[U_DT + (lane & 15)]; rq[j] = *(const u32x2*)(ur + U_MQ + 4 * lane); rkv[j] = *(const unsigned*)(ur + U_MKV + 2 * lane); rkr[j] = ur[U_MKR + (lane & 31)]; }
        {
            int lane_ = lane; asm volatile("" : "+v"(lane_)); const int lane = lane_;
            u32x2 raw[12][3];
#pragma unroll
            for (int j = 0; j < 12; ++j) { const int tt = t0 + j - 2; const bool ok = tt >= 0 && tt < L;
#pragma unroll
                for (int c3 = 0; c3 < 3; ++c3) raw[j][c3] = ok ? *(const u32x2*)((u0 - 2 * UP) + (unsigned)(j * UP + U_XBC + 4 * lane + 256 * c3)) : (u32x2){0u, 0u}; }
#pragma unroll
            for (int c3 = 0; c3 < 3; ++c3) { const unsigned ch = 4 * lane + 256 * c3; const f32x4 bias = *(const f32x4*)(cb + ch); f32x4 wv[5];
#pragma unroll
                for (int w = 0; w < 5; ++w) wv[w] = *(const f32x4*)(cw + (w * 768u + ch));
#pragma unroll
                for (int j = 0; j < 8; ++j) { f32x4 acc = bias;
#pragma unroll
                    for (int w = 0; w < 5; ++w) { const u32x2 rw = raw[j + w][c3]; acc.x += bflo(rw.x) * wv[w].x; acc.y += bfhi(rw.x) * wv[w].y; acc.z += bflo(rw.y) * wv[w].z; acc.w += bfhi(rw.y) * wv[w].w; }
                    u32x2 o; o.x = pk2(pg8::silu_f(acc.x), pg8::silu_f(acc.y)); o.y = pk2(pg8::silu_f(acc.z), pg8::silu_f(acc.w)); *(u32x2*)((C.xbc() + (size_t)(r0 + j) * 768) + ch) = o; } }
        }
        { int lane_ = lane; asm volatile("" : "+v"(lane_)); const int lane = lane_;
#pragma unroll
        for (int q = 0; q < 2; ++q) { const int idx = 16 * tile + 2 * wave + q, b = idx >> 9, sx = idx & 511; const size_t krow = 8192 + (size_t)b * 1536 + sx;
            *(LAS unsigned*)(sCKV + (64 + 2 * wave + q) * 136 + 2 * lane) = pk2(cv[q].x, cv[q].y);
            if (lane < 16) *(unsigned*)(C.krall() + krow * 32 + 2 * lane) = pk2(ck[q].x, ck[q].y); }
#pragma unroll
        for (int j = 0; j < 8; ++j) { const int r = r0 + j, t = t0 + j;
            if (lane < 16) { const float v = bf2f(rdt[j]) + dtbias; const float dt = v > 20.f ? v : 0.6931471805599453f * __builtin_amdgcn_logf(1.0f + __builtin_amdgcn_exp2f(1.4426950408889634f * v)); C.dtb()[(size_t)r * 16 + lane] = dt; C.lab()[(size_t)r * 16 + lane] = -dt * aexp; }
            { const float x0 = bflo(rq[j].x), x1 = bfhi(rq[j].x), x2 = bflo(rq[j].y), x3 = bfhi(rq[j].y);
              const float rstd = rsqrtf(wave_sum(x0 * x0 + x1 * x1 + x2 * x2 + x3 * x3) * (1.f / 256) + EPS);
              u32x2 o; o.x = pk2(x0 * rstd * qnw.x, x1 * rstd * qnw.y); o.y = pk2(x2 * rstd * qnw.z, x3 * rstd * qnw.w); *(LAS u32x2*)(sQC + (wave * 8 + j) * 264 + 4 * lane) = o; }
            const size_t krow = ctx ? (size_t)r : 8192 + (size_t)b * 1536 + 512 + t;
            { const float x0 = bflo(rkv[j]), x1 = bfhi(rkv[j]); const float rstd = rsqrtf(wave_sum(x0 * x0 + x1 * x1) * (1.f / 128) + EPS);
              const float y0 = x0 * rstd * kvnw.x, y1 = x1 * rstd * kvnw.y; *(LAS unsigned*)(sCKV + (wave * 8 + j) * 136 + 2 * lane) = pk2(y0, y1);
              if (ctx) *(f32x2*)(C.out + O_CKV + (((size_t)b * DEPTH + layer) * 256 + t) * 128 + 2 * lane) = (f32x2){y0, y1}; }
            { const float v = bf2f(rkr[j]); const float partner = dppf<0x128>(v); float o = v;
              if (!ctx) { const float rot = (lane & 8) ? partner : -partner; o = v * C.ropec()[t * 32 + (lane & 31)] + rot * C.ropes()[t * 32 + (lane & 31)]; }
              if (lane < 32) { C.krall()[krow * 32 + lane] = (bf16_t)(pk2(o, 0.f) & 0xffffu); if (ctx) C.out[O_KR + (((size_t)b * DEPTH + layer) * 256 + t) * 32 + lane] = v; } }
        }
        }
        __syncthreads();
        __builtin_amdgcn_sched_barrier(0);
        {
            int lane_ = lane; asm volatile("" : "+v"(lane_)); const int fr = lane_ & 15, fq = lane_ >> 4;
            const bf16_t* Bq = wl + WL_UQ + (unsigned)((48 * wave + fr) * 256 + fq * 8);
            f32x4 acc[4][3];
#pragma unroll
            for (int mt = 0; mt < 4; ++mt)
#pragma unroll
                for (int j = 0; j < 3; ++j) acc[mt][j] = (f32x4){0.f, 0.f, 0.f, 0.f};
#pragma unroll
            for (int kh = 0; kh < 2; ++kh) {
                bf16x8 xq[3][4];
#pragma unroll
                for (int j = 0; j < 3; ++j)
#pragma unroll
                    for (int k4 = 0; k4 < 4; ++k4) xq[j][k4] = *(const bf16x8*)(Bq + (j * 16 * 256 + (4 * kh + k4) * 32));
                __builtin_amdgcn_sched_barrier(0);
#pragma unroll
                for (int k4 = 0; k4 < 4; ++k4) { const int kk = 4 * kh + k4; bf16x8 ya[4];
#pragma unroll
                    for (int mt = 0; mt < 4; ++mt) ya[mt] = *(const LAS bf16x8*)(sQC + (16 * mt + fr) * 264 + kk * 32 + fq * 8);
#pragma unroll
                    for (int mt = 0; mt < 4; ++mt)
#pragma unroll
                        for (int j = 0; j < 3; ++j) acc[mt][j] = MFMA16P(xq[j][k4], ya[mt], acc[mt][j]); }
                __builtin_amdgcn_sched_barrier(0);
            }
#pragma unroll
            for (int mt = 0; mt < 4; ++mt) { bf16_t* qrow = C.qb() + (unsigned)((tile * 64 + 16 * mt + fr) * 512 + 48 * wave + 4 * fq);
#pragma unroll
                for (int j = 0; j < 3; ++j) { u32x2 o; o.x = pk2(acc[mt][j][0], acc[mt][j][1]); o.y = pk2(acc[mt][j][2], acc[mt][j][3]); *(u32x2*)(qrow + 16 * j) = o; } }
        }
        {
            __builtin_amdgcn_sched_barrier(0);
            int lane_ = lane; asm volatile("" : "+v"(lane_)); const int fr = lane_ & 15, fq = lane_ >> 4;
            const bf16_t* Bk = wl + WL_UKV + (unsigned)((64 * wave + fr) * 128 + fq * 8);
            bf16x8 xk[4][4];
#pragma unroll
            for (int j = 0; j < 4; ++j)
#pragma unroll
                for (int kk = 0; kk < 4; ++kk) xk[j][kk] = *(const bf16x8*)(Bk + (j * 16 * 128 + kk * 32));
            f32x4 acc[5][4];
#pragma unroll
            for (int mt = 0; mt < 5; ++mt)
#pragma unroll
                for (int j = 0; j < 4; ++j) acc[mt][j] = (f32x4){0.f, 0.f, 0.f, 0.f};
#pragma unroll
            for (int kk = 0; kk < 4; ++kk) { bf16x8 ya[5];
#pragma unroll
                for (int mt = 0; mt < 5; ++mt) ya[mt] = *(const LAS bf16x8*)(sCKV + (16 * mt + fr) * 136 + kk * 32 + fq * 8);
#pragma unroll
                for (int mt = 0; mt < 5; ++mt)
#pragma unroll
                    for (int j = 0; j < 4; ++j) acc[mt][j] = MFMA16P(xk[j][kk], ya[mt], acc[mt][j]); }
#pragma unroll
            for (int mt = 0; mt < 5; ++mt) { unsigned krow;
                if (mt < 4) { const int r = tile * 64 + 16 * mt + fr; krow = r < NCTXR ? (unsigned)r : 8192u + (unsigned)(((r - NCTXR) >> 10) * 1536 + 512 + ((r - NCTXR) & 1023)); }
                else { const int idx = 16 * tile + fr; krow = 8192u + (unsigned)((idx >> 9) * 1536 + (idx & 511)); }
                bf16_t* kvrow = C.kvb() + (krow * 512u + (unsigned)(64 * wave + 4 * fq));
#pragma unroll
                for (int j = 0; j < 4; ++j) { u32x2 o; o.x = pk2(acc[mt][j][0], acc[mt][j][1]); o.y = pk2(acc[mt][j][2], acc[mt][j][3]); *(u32x2*)(kvrow + 16 * j) = o; } }
        }
    }
}

#define LDS_BARRIER() do { asm volatile("s_waitcnt lgkmcnt(0)" ::: "memory"); __builtin_amdgcn_s_barrier(); asm volatile("" ::: "memory"); } while (0)
#define SCHED_FENCE() __builtin_amdgcn_sched_barrier(0)
#define MFMA16(x, y, c) __builtin_amdgcn_mfma_f32_16x16x32_bf16((x), (y), (c), 0, 0, 0)
constexpr int SC_Q = 0, SC_K = 18432, SC_KT = 36864, SC_VT = 54272, SC_P = 71680, SC_Q2 = 106496, SC_HT = 124928, SC_CUM = 134144, SC_LA = 134656, SC_DT = 135168;

__device__ __forceinline__ void scan_unit(Ctx& C, int layer, int kind  , bool ctx, int b, int h, int dir) {
    LAS unsigned char* lds = C.lds;
    TIDS; const int wid = wave, fr = lane & 15, fq = lane >> 4;
    const int L = ctx ? 256 : 1024, R0 = ctx ? b * 256 : NCTXR + b * 1024, nch = L >> 7;
    const bf16_t *qp, *kp, *vp; int pitch; float kscale, la_const = 0.f; bf16_t* yout; int ypitch; int NH;
    if (kind == 0) { const int g = h >> 2; qp = C.xbc() + 640 + g * 64; kp = C.xbc() + 512 + g * 64; vp = C.xbc() + h * 64; pitch = 768; kscale = 1.f;
        yout = C.yssd() + (size_t)dir * NTOK * 512 + h * 64; ypitch = 512; NH = 8; }
    else { qp = C.ub() + U_RQ + h * 64; kp = C.ub() + U_RK + h * 64; vp = C.ub() + U_RV + h * 64; pitch = UP; kscale = 0.125f;
        const float x = C.in(18)[layer * 8 + dir * 4 + h]; la_const = -log1pf(__expf(-x));
        yout = C.yret() + (size_t)dir * NTOK * 256 + h * 64; ypitch = 256; NH = 4; }
    const float* labp = C.lab() + dir * 8 + h; const float* dtbp = C.dtb() + dir * 8 + h;
    LAS bf16_t* sQ = (LAS bf16_t*)(lds + SC_Q); LAS bf16_t* sK = (LAS bf16_t*)(lds + SC_K); LAS bf16_t* sKT = (LAS bf16_t*)(lds + SC_KT); LAS bf16_t* sVT = (LAS bf16_t*)(lds + SC_VT);
    LAS bf16_t* sP = (LAS bf16_t*)(lds + SC_P); LAS bf16_t* sQ2 = (LAS bf16_t*)(lds + SC_Q2); LAS bf16_t* sHT = (LAS bf16_t*)(lds + SC_HT);
    LAS float* sCumAll = (LAS float*)(lds + SC_CUM);
    const int tn = wid >> 1, tp0 = (wid & 1) * 2;
    f32x4 Hacc[2];
    if (!ctx) { const float* st = (kind == 0 ? C.in(3) : C.in(4)) + ((((size_t)b * DEPTH + layer) * 2 + dir) * NH + h) * 4096;
#pragma unroll
        for (int q = 0; q < 2; ++q)
#pragma unroll
            for (int e = 0; e < 4; ++e) Hacc[q][e] = st[(16 * tn + 4 * fq + e) * 64 + 16 * (tp0 + q) + fr]; }
    else { Hacc[0] = (f32x4){0.f, 0.f, 0.f, 0.f}; Hacc[1] = Hacc[0]; }
    const int li = tid >> 3, p8 = tid & 7;
    u32x4 qv[2], kv[2], vv[2]; float dt_r[2];
#define SCAN_ISSUE(cc) do { _Pragma("unroll") for (int ps_ = 0; ps_ < 2; ++ps_) { const int pos_ = (cc) * 128 + li + 64 * ps_, t_ = dir ? L - 1 - pos_ : pos_; const size_t r_ = (size_t)(R0 + t_); \
        qv[ps_] = *(const u32x4*)(qp + r_ * pitch + p8 * 8); kv[ps_] = *(const u32x4*)(kp + r_ * pitch + p8 * 8); vv[ps_] = *(const u32x4*)(vp + r_ * pitch + p8 * 8); \
        dt_r[ps_] = kind == 0 ? dtbp[r_ * 16] : 1.0f; } } while (0)
    float cs_e = 0.f, cs_o = 0.f;
    if (wid < nch) { float a[2];
#pragma unroll
        for (int e = 0; e < 2; ++e) { const int pos = wid * 128 + 2 * lane + e, t = dir ? L - 1 - pos : pos; a[e] = (kind == 0 ? labp[(size_t)(R0 + t) * 16] : la_const) * 1.4426950408889634f; }
        float sc = a[0] + a[1];
#pragma unroll
        for (int o = 1; o < 64; o <<= 1) { const float v = __shfl_up(sc, o); if (lane >= o) sc += v; }
        cs_o = sc; cs_e = sc - a[1]; }
    SCAN_ISSUE(0);
    __syncthreads();
#pragma unroll
    for (int q = 0; q < 2; ++q) { u32x2 o; o.x = pk2(Hacc[q][0], Hacc[q][1]); o.y = pk2(Hacc[q][2], Hacc[q][3]); *(LAS u32x2*)(sHT + (16 * (tp0 + q) + fr) * 72 + 16 * tn + 4 * fq) = o; }
    if (wid < nch) *(LAS f32x2*)(sCumAll + wid * 128 + 2 * lane) = (f32x2){cs_e, cs_o};
    __syncthreads();
    for (int c = 0; c < nch; ++c) {
        const LAS float* sCum = sCumAll + c * 128;
        float cum_i[2]; const float cum_last = sCum[127];
#pragma unroll
        for (int ps = 0; ps < 2; ++ps) cum_i[ps] = sCum[li + 64 * ps];
#pragma unroll
        for (int ps = 0; ps < 2; ++ps) {
            const int i = li + 64 * ps, isw = i ^ (8 * p8);
            const float te = __builtin_amdgcn_exp2f(cum_last - cum_i[ps]) * kscale, dtv = dt_r[ps];
            *(LAS u32x4*)(sQ + i * 72 + p8 * 8) = qv[ps]; *(LAS u32x4*)(sK + i * 72 + p8 * 8) = kv[ps];
            const unsigned ka[4] = {kv[ps].x, kv[ps].y, kv[ps].z, kv[ps].w}, va[4] = {vv[ps].x, vv[ps].y, vv[ps].z, vv[ps].w};
#pragma unroll
            for (int e = 0; e < 4; ++e) {
                const unsigned kt = pk2(bflo(ka[e]) * te, bfhi(ka[e]) * te), vt = pk2(bflo(va[e]) * dtv, bfhi(va[e]) * dtv);
                sKT[(p8 * 8 + 2 * e) * 136 + isw] = (bf16_t)(kt & 0xffffu); sKT[(p8 * 8 + 2 * e + 1) * 136 + isw] = (bf16_t)(kt >> 16);
                sVT[(p8 * 8 + 2 * e) * 136 + isw] = (bf16_t)(vt & 0xffffu); sVT[(p8 * 8 + 2 * e + 1) * 136 + isw] = (bf16_t)(vt >> 16); }
        }
        if (c + 1 < nch) SCAN_ISSUE(c + 1);
        LDS_BARRIER();
        {
            const float kadj = kind == 0 ? 0.f : -3.f;
            int prt[5], pjt[5];
#pragma unroll
            for (int t = 0; t < 5; ++t) { const int p = wid + 8 * t; int rt = 0;
#pragma unroll
                for (int k = 1; k < 8; ++k) if (p >= k * (k + 1) / 2) rt = k;
                prt[t] = rt; pjt[t] = p - rt * (rt + 1) / 2; }
            {
                bf16x8 yq[4][2], xk[4][2]; f32x4 cj[4], s4[4]; float cumr[4];
#pragma unroll
                for (int t = 0; t < 4; ++t) { const int i = 16 * prt[t] + fr, jr = 16 * pjt[t] + fr;
                    yq[t][0] = *(const LAS bf16x8*)(sQ + i * 72 + fq * 8); yq[t][1] = *(const LAS bf16x8*)(sQ + i * 72 + 32 + fq * 8);
                    xk[t][0] = *(const LAS bf16x8*)(sK + jr * 72 + fq * 8); xk[t][1] = *(const LAS bf16x8*)(sK + jr * 72 + 32 + fq * 8);
                    cj[t] = *(const LAS f32x4*)(sCum + 16 * pjt[t] + 4 * fq); cumr[t] = sCum[i] + kadj; }
                SCHED_FENCE();
#pragma unroll
                for (int t = 0; t < 4; ++t) s4[t] = MFMA16(xk[t][0], yq[t][0], ((f32x4){0.f, 0.f, 0.f, 0.f}));
#pragma unroll
                for (int t = 0; t < 4; ++t) s4[t] = MFMA16(xk[t][1], yq[t][1], s4[t]);
                SCHED_FENCE();
#pragma unroll
                for (int t = 0; t < 4; ++t) { const int i = 16 * prt[t] + fr; float pv[4];
#pragma unroll
                    for (int e = 0; e < 4; ++e) { const int j = 16 * pjt[t] + 4 * fq + e; pv[e] = s4[t][e] * __builtin_amdgcn_exp2f(j <= i ? cumr[t] - cj[t][e] : -1e30f); }
                    u32x2 o; o.x = pk2(pv[0], pv[1]); o.y = pk2(pv[2], pv[3]); *(LAS u32x2*)(sP + i * 136 + 16 * pjt[t] + 4 * fq) = o; }
            }
            if (wid < 4) {
                const int i = 16 * prt[4] + fr, jr = 16 * pjt[4] + fr;
                const bf16x8 y0 = *(const LAS bf16x8*)(sQ + i * 72 + fq * 8), y1 = *(const LAS bf16x8*)(sQ + i * 72 + 32 + fq * 8);
                const bf16x8 x0 = *(const LAS bf16x8*)(sK + jr * 72 + fq * 8), x1 = *(const LAS bf16x8*)(sK + jr * 72 + 32 + fq * 8);
                const f32x4 cj = *(const LAS f32x4*)(sCum + 16 * pjt[4] + 4 * fq); const float cumr = sCum[i] + kadj;
                f32x4 s4 = MFMA16(x0, y0, ((f32x4){0.f, 0.f, 0.f, 0.f})); s4 = MFMA16(x1, y1, s4);
                float pv[4];
#pragma unroll
                for (int e = 0; e < 4; ++e) { const int j = 16 * pjt[4] + 4 * fq + e; pv[e] = s4[e] * __builtin_amdgcn_exp2f(j <= i ? cumr - cj[e] : -1e30f); }
                u32x2 o; o.x = pk2(pv[0], pv[1]); o.y = pk2(pv[2], pv[3]); *(LAS u32x2*)(sP + i * 136 + 16 * pjt[4] + 4 * fq) = o;
            } else {
                const int rt = 2 * (wid - 4); *(LAS u32x2*)(sP + (16 * rt + fr) * 136 + 16 * (rt + 1) + 4 * fq) = (u32x2){0u, 0u};
            }
        }
        LDS_BARRIER();
        {
            const int i = 16 * wid + fr; f32x4 acc[4];
            {
                bf16x8 yq[2], xh[2][4], yp, xv[4]; f32x4 ah[4];
#pragma unroll
                for (int kk = 0; kk < 2; ++kk) { yq[kk] = *(const LAS bf16x8*)(sQ + i * 72 + kk * 32 + fq * 8);
#pragma unroll
                    for (int pt = 0; pt < 4; ++pt) xh[kk][pt] = *(const LAS bf16x8*)(sHT + (16 * pt + fr) * 72 + kk * 32 + fq * 8); }
                yp = *(const LAS bf16x8*)(sP + i * 136 + fq * 8);
#pragma unroll
                for (int pt = 0; pt < 4; ++pt) xv[pt] = *(const LAS bf16x8*)(sVT + (16 * pt + fr) * 136 + ((fq * 8) ^ (8 * ((2 * pt + (fr >> 3)) & 7))));
                const float ecr = __builtin_amdgcn_exp2f(sCum[i]);
                SCHED_FENCE();
#pragma unroll
                for (int pt = 0; pt < 4; ++pt) ah[pt] = MFMA16(xh[0][pt], yq[0], ((f32x4){0.f, 0.f, 0.f, 0.f}));
#pragma unroll
                for (int pt = 0; pt < 4; ++pt) acc[pt] = MFMA16(xv[pt], yp, ((f32x4){0.f, 0.f, 0.f, 0.f}));
#pragma unroll
                for (int pt = 0; pt < 4; ++pt) ah[pt] = MFMA16(xh[1][pt], yq[1], ah[pt]);
                SCHED_FENCE();
#pragma unroll
                for (int pt = 0; pt < 4; ++pt) acc[pt] = acc[pt] + ah[pt] * ecr;
            }
#define SCAN_PV_STEP(kk_) do { bf16x8 yp_ = *(const LAS bf16x8*)(sP + i * 136 + (kk_) * 32 + fq * 8); bf16x8 xv_[4]; \
                _Pragma("unroll") for (int pt = 0; pt < 4; ++pt) xv_[pt] = *(const LAS bf16x8*)(sVT + (16 * pt + fr) * 136 + (((kk_) * 32 + fq * 8) ^ (8 * ((2 * pt + (fr >> 3)) & 7)))); \
                SCHED_FENCE(); \
                _Pragma("unroll") for (int pt = 0; pt < 4; ++pt) acc[pt] = MFMA16(xv_[pt], yp_, acc[pt]); \
                SCHED_FENCE(); } while (0)
            if (wid >= 2) SCAN_PV_STEP(1);
            if (wid >= 4) SCAN_PV_STEP(2);
            if (wid >= 6) SCAN_PV_STEP(3);
#undef SCAN_PV_STEP
            const int pos = c * 128 + i, t = dir ? L - 1 - pos : pos; bf16_t* yr = yout + (size_t)(R0 + t) * ypitch;
#pragma unroll
            for (int pt = 0; pt < 4; ++pt) { u32x2 o; o.x = pk2(acc[pt][0], acc[pt][1]); o.y = pk2(acc[pt][2], acc[pt][3]); *(u32x2*)(yr + 16 * pt + 4 * fq) = o; }
        }
        {
            const float dec = __builtin_amdgcn_exp2f(cum_last);
            bf16x8 xk[4], yv[2][4];
#pragma unroll
            for (int kk = 0; kk < 4; ++kk) { xk[kk] = *(const LAS bf16x8*)(sKT + (16 * tn + fr) * 136 + ((kk * 32 + fq * 8) ^ (8 * ((2 * tn + (fr >> 3)) & 7))));
#pragma unroll
                for (int q = 0; q < 2; ++q) yv[q][kk] = *(const LAS bf16x8*)(sVT + (16 * (tp0 + q) + fr) * 136 + ((kk * 32 + fq * 8) ^ (8 * ((2 * (tp0 + q) + (fr >> 3)) & 7)))); }
            Hacc[0] = Hacc[0] * dec; Hacc[1] = Hacc[1] * dec;
            SCHED_FENCE();
#pragma unroll
            for (int kk = 0; kk < 4; ++kk)
#pragma unroll
                for (int q = 0; q < 2; ++q) Hacc[q] = MFMA16(xk[kk], yv[q][kk], Hacc[q]);
            SCHED_FENCE();
        }
        LDS_BARRIER();
#pragma unroll
        for (int q = 0; q < 2; ++q) { u32x2 o; o.x = pk2(Hacc[q][0], Hacc[q][1]); o.y = pk2(Hacc[q][2], Hacc[q][3]); *(LAS u32x2*)(sHT + (16 * (tp0 + q) + fr) * 72 + 16 * tn + 4 * fq) = o; }
    }
#undef SCAN_ISSUE
    if (ctx) { float* so = C.out + (kind == 0 ? O_SSD : O_RET) + ((((size_t)b * DEPTH + layer) * 2 + dir) * NH + h) * 4096;
#pragma unroll
        for (int q = 0; q < 2; ++q)
#pragma unroll
            for (int e = 0; e < 4; ++e) so[(16 * tn + 4 * fq + e) * 64 + 16 * (tp0 + q) + fr] = Hacc[q][e]; }
}

constexpr int AT_K = 0, AT_VT = 26624, AT_BUF = 44032;
template <int MODE = 0>
__device__ __forceinline__ void attn_unit(Ctx& C, bool ctx, int b, int h, int qb) {
    LAS unsigned char* lds = C.lds;
    TIDS; const int wid = wave, fr = lane & 15, fq = lane >> 4;
    const int R0 = ctx ? b * 256 : NCTXR + b * 1024, KR0 = ctx ? b * 256 : 8192 + b * 1536, S = ctx ? 256 : 1536, nkt = S >> 7;
    const int tq = qb * 128 + 16 * wid + fr; const size_t rq = (size_t)(R0 + tq);
    const float SCL = 0.10206207261596577f * 1.4426950408889634f;
    const int lj = tid >> 3, p8 = tid & 7, rj = tid >> 2, rp = tid & 3;
    const bf16_t* kvbase = C.kvb() + (size_t)(KR0 + lj) * 512 + h * 128 + p8 * 8; const bf16_t* krbase = C.krall() + (size_t)(KR0 + rj) * 32 + rp * 8;
    u32x4 kn[2], vn[2], kr8;
#define ATT_ISSUE(kt_) do { const bf16_t* kvrow_ = kvbase + (size_t)(kt_) * 128 * 512; kn[0] = *(const u32x4*)(kvrow_); kn[1] = *(const u32x4*)(kvrow_ + 64 * 512); \
        vn[0] = *(const u32x4*)(kvrow_ + 64); vn[1] = *(const u32x4*)(kvrow_ + 64 * 512 + 64); kr8 = *(const u32x4*)(krbase + (size_t)(kt_) * 128 * 32); } while (0)
    ATT_ISSUE(0);
    bf16x8 qf[3];
    { const bf16_t* qrow = C.qb() + rq * 512 + h * 96;
#pragma unroll
      for (int kk = 0; kk < 3; ++kk) { const u32x4 raw = *(const u32x4*)(qrow + kk * 32 + fq * 8); float x[8] = {bflo(raw.x), bfhi(raw.x), bflo(raw.y), bfhi(raw.y), bflo(raw.z), bfhi(raw.z), bflo(raw.w), bfhi(raw.w)};
          if (kk == 2 && !ctx) {
#pragma unroll
              for (int e = 0; e < 8; ++e) { const float partner = __shfl_xor(x[e], 16); const float rot = (fq & 1) ? partner : -partner; const int d = fq * 8 + e;
                  x[e] = x[e] * C.ropec()[tq * 32 + d] + rot * C.ropes()[tq * 32 + d]; } }
          u32x4 o; o.x = pk2(x[0] * SCL, x[1] * SCL); o.y = pk2(x[2] * SCL, x[3] * SCL); o.z = pk2(x[4] * SCL, x[5] * SCL); o.w = pk2(x[6] * SCL, x[7] * SCL);
          qf[kk] = __builtin_bit_cast(bf16x8, o); } }
    float m_run = -1e30f, l_run = 0.f; f32x4 o[4];
#pragma unroll
    for (int pt = 0; pt < 4; ++pt) o[pt] = (f32x4){0.f, 0.f, 0.f, 0.f};
    __syncthreads();
    for (int kt = 0; kt < nkt; ++kt) {
        LAS bf16_t* sK = (LAS bf16_t*)(lds + (kt & 1) * AT_BUF + AT_K); LAS bf16_t* sVT = (LAS bf16_t*)(lds + (kt & 1) * AT_BUF + AT_VT);
        if (MODE != 2) { *(LAS u32x4*)(sK + rj * 104 + 64 + rp * 8) = kr8;
#pragma unroll
          for (int ps = 0; ps < 2; ++ps) { const int j = lj + 64 * ps, jsw = j ^ (8 * p8); *(LAS u32x4*)(sK + j * 104 + p8 * 8) = kn[ps];
              const unsigned va[4] = {vn[ps].x, vn[ps].y, vn[ps].z, vn[ps].w};
#pragma unroll
              for (int e = 0; e < 4; ++e) { sVT[(p8 * 8 + 2 * e) * 136 + jsw] = (bf16_t)(va[e] & 0xffffu); sVT[(p8 * 8 + 2 * e + 1) * 136 + jsw] = (bf16_t)(va[e] >> 16); } } }
        if (MODE != 2 && kt + 1 < nkt) ATT_ISSUE(kt + 1);
        LDS_BARRIER();
        if (MODE == 1) continue;
        f32x4 s[8]; float mx = -1e30f;
        {
            bf16x8 kf[8][3];
#pragma unroll
            for (int jt = 0; jt < 8; ++jt)
#pragma unroll
                for (int kk = 0; kk < 3; ++kk) kf[jt][kk] = *(const LAS bf16x8*)(sK + (16 * jt + fr) * 104 + kk * 32 + fq * 8);
            SCHED_FENCE();
#pragma unroll
            for (int jt = 0; jt < 8; ++jt) s[jt] = MFMA16(kf[jt][0], qf[0], ((f32x4){0.f, 0.f, 0.f, 0.f}));
#pragma unroll
            for (int kk = 1; kk < 3; ++kk)
#pragma unroll
                for (int jt = 0; jt < 8; ++jt) s[jt] = MFMA16(kf[jt][kk], qf[kk], s[jt]);
            SCHED_FENCE();
        }
        u32x2 va[4][4], vb[4][4];
#pragma unroll
        for (int kk = 0; kk < 4; ++kk)
#pragma unroll
            for (int pt = 0; pt < 4; ++pt) { const LAS bf16_t* vr = sVT + (16 * pt + fr) * 136; const int sw = 8 * ((2 * pt + (fr >> 3)) & 7); va[kk][pt] = *(const LAS u32x2*)(vr + ((32 * kk + 4 * fq) ^ sw)); vb[kk][pt] = *(const LAS u32x2*)(vr + ((32 * kk + 16 + 4 * fq) ^ sw)); }
        SCHED_FENCE();
#pragma unroll
        for (int jt = 0; jt < 8; ++jt) mx = fmaxf(mx, fmaxf(fmaxf(s[jt][0], s[jt][1]), fmaxf(s[jt][2], s[jt][3])));
        mx = fmaxf(mx, __shfl_xor(mx, 16)); mx = fmaxf(mx, __shfl_xor(mx, 32));
        const float m_new = fmaxf(m_run, mx), alpha = __builtin_amdgcn_exp2f(m_run - m_new); m_run = m_new;
        float ls = 0.f;
#pragma unroll
        for (int jt = 0; jt < 8; ++jt)
#pragma unroll
            for (int e = 0; e < 4; ++e) { s[jt][e] = __builtin_amdgcn_exp2f(s[jt][e] - m_new); ls += s[jt][e]; }
        l_run = l_run * alpha + ls;
#pragma unroll
        for (int pt = 0; pt < 4; ++pt) o[pt] = o[pt] * alpha;
        bf16x8 yp[4];
#pragma unroll
        for (int kk = 0; kk < 4; ++kk) { u32x4 yw; yw.x = pk2(s[2 * kk][0], s[2 * kk][1]); yw.y = pk2(s[2 * kk][2], s[2 * kk][3]); yw.z = pk2(s[2 * kk + 1][0], s[2 * kk + 1][1]); yw.w = pk2(s[2 * kk + 1][2], s[2 * kk + 1][3]);
            yp[kk] = __builtin_bit_cast(bf16x8, yw); }
        SCHED_FENCE();
#pragma unroll
        for (int kk = 0; kk < 4; ++kk)
#pragma unroll
            for (int pt = 0; pt < 4; ++pt) { const u32x4 xw = (u32x4){va[kk][pt].x, va[kk][pt].y, vb[kk][pt].x, vb[kk][pt].y}; o[pt] = MFMA16(__builtin_bit_cast(bf16x8, xw), yp[kk], o[pt]); }
        SCHED_FENCE();
    }
#undef ATT_ISSUE
    float l = l_run + __shfl_xor(l_run, 16); l += __shfl_xor(l, 32); const float inv = 1.0f / l;
    if (MODE != 0 && l != 12345.678f) return;
    bf16_t* orow = C.abuf() + rq * 1024 + 768 + h * 64;
#pragma unroll
    for (int pt = 0; pt < 4; ++pt) { u32x2 w; w.x = pk2(o[pt][0] * inv, o[pt][1] * inv); w.y = pk2(o[pt][2] * inv, o[pt][3] * inv); *(u32x2*)(orow + 16 * pt + 4 * fq) = w; }
}

__device__ __forceinline__ int mix_unit_of(int bid, int G, int k) {
    if (G != 256) { const int idx = bid + k * G; return idx < 1472 ? idx : -1; }
    if (k == 0) return bid;
    if (bid < 192) {
        if (k == 1) return 256 + bid;
        if (k == 2 || k == 3) return 448 + 384 + 2 * bid + (k - 2);
        if (k == 4) return 448 + 768 + 64 + bid;
        return -1; }
    const int j = bid - 192;
    if (k <= 6) return 448 + 6 * j + (k - 1);
    if (k == 7) return 448 + 768 + j;
    return -1;
}
__device__ __forceinline__ void phase_mixers(Ctx& C, int layer) {
    for (int k = 0;; ++k) {
        int idx = mix_unit_of(C.bid, C.G, k); if (idx < 0) break;
        if (idx < 256) { const int rest = idx >> 3; attn_unit<0>(C, false, idx & 7, rest >> 3, rest & 7); continue; }
        idx -= 256;
        if (idx < 192) { const int b = idx & 7, rem = idx >> 3;
            if (rem < 16) scan_unit(C, layer, 0, false, b, rem >> 1, rem & 1); else scan_unit(C, layer, 1, false, b, (rem - 16) >> 1, rem & 1);
            continue; }
        idx -= 192;
        if (idx < 512) { scan_unit(C, layer, 0, true, idx >> 4, (idx >> 1) & 7, idx & 1); continue; }
        idx -= 512;
        if (idx < 256) { scan_unit(C, layer, 1, true, idx >> 3, (idx >> 1) & 3, idx & 1); continue; }
        idx -= 256;
        attn_unit<0>(C, true, idx >> 3, (idx >> 1) & 3, idx & 1);
    }
}

__device__ __forceinline__ void phase_mix(Ctx& C, int layer) {
    TIDS;
    const int gw = C.bid * NWAVES + wave, NGW = C.G * NWAVES;
    const float Dh = C.in(16)[layer * 8 + (lane >> 3)];
    const f32x4 nw0 = *(const f32x4*)(C.in(17) + layer * 512 + 8 * lane), nw1 = *(const f32x4*)(C.in(17) + layer * 512 + 8 * lane + 4);
    const f32x4 gw4 = *(const f32x4*)(C.in(19) + layer * 256 + 4 * lane);
    for (int r0 = gw; r0 < NTOK; r0 += 2 * NGW) {
        u32x4 yf[2], yb[2], xs[2], z[2]; u32x2 of[2], ob[2], g[2]; int rr[2];
#pragma unroll
        for (int q = 0; q < 2; ++q) { const int r = xcd_row(r0 + q * NGW < NTOK ? r0 + q * NGW : r0, C.G); rr[q] = r; const bf16_t* ur = C.ub() + (size_t)r * UP;
            yf[q] = *(const u32x4*)(C.yssd() + (size_t)r * 512 + 8 * lane); yb[q] = *(const u32x4*)(C.yssd() + (size_t)(NTOK + r) * 512 + 8 * lane);
            xs[q] = *(const u32x4*)(C.xbc() + (size_t)r * 768 + 8 * lane); z[q] = *(const u32x4*)(ur + 8 * lane);
            of[q] = *(const u32x2*)(C.yret() + (size_t)r * 256 + 4 * lane); ob[q] = *(const u32x2*)(C.yret() + (size_t)(NTOK + r) * 256 + 4 * lane); g[q] = *(const u32x2*)(ur + U_RG + 4 * lane); }
#pragma unroll
        for (int q = 0; q < 2; ++q) { const int r = rr[q];
          { const unsigned yfa[4] = {yf[q].x, yf[q].y, yf[q].z, yf[q].w}, yba[4] = {yb[q].x, yb[q].y, yb[q].z, yb[q].w}, xsa[4] = {xs[q].x, xs[q].y, xs[q].z, xs[q].w}, za[4] = {z[q].x, z[q].y, z[q].z, z[q].w};
            float v[8]; float ss = 0.f;
#pragma unroll
            for (int e = 0; e < 4; ++e) { v[2 * e] = (bflo(yfa[e]) + bflo(yba[e]) + Dh * bflo(xsa[e])) * pg8::silu_f(bflo(za[e])); v[2 * e + 1] = (bfhi(yfa[e]) + bfhi(yba[e]) + Dh * bfhi(xsa[e])) * pg8::silu_f(bfhi(za[e]));
                ss += v[2 * e] * v[2 * e] + v[2 * e + 1] * v[2 * e + 1]; }
            const float rstd = rsqrtf(wave_sum(ss) * (1.f / 512) + EPS);
            u32x4 o; o.x = pk2(v[0] * rstd * nw0.x, v[1] * rstd * nw0.y); o.y = pk2(v[2] * rstd * nw0.z, v[3] * rstd * nw0.w); o.z = pk2(v[4] * rstd * nw1.x, v[5] * rstd * nw1.y); o.w = pk2(v[6] * rstd * nw1.z, v[7] * rstd * nw1.w);
            *(u32x4*)(C.abuf() + (size_t)r * 1024 + 8 * lane) = o; }
          { const float o0 = bflo(of[q].x) + bflo(ob[q].x), o1 = bfhi(of[q].x) + bfhi(ob[q].x), o2 = bflo(of[q].y) + bflo(ob[q].y), o3 = bfhi(of[q].y) + bfhi(ob[q].y);
            const float s4 = row16_sum((o0 + o1) + (o2 + o3));
            const float mu = s4 * (1.f / 64); const float d0 = o0 - mu, d1 = o1 - mu, d2 = o2 - mu, d3 = o3 - mu; const float vq = row16_sum((d0 * d0 + d1 * d1) + (d2 * d2 + d3 * d3));
            const float rs = rsqrtf(vq * (1.f / 64) + EPS);
            u32x2 o; o.x = pk2(d0 * rs * gw4.x * pg8::silu_f(bflo(g[q].x)), d1 * rs * gw4.y * pg8::silu_f(bfhi(g[q].x))); o.y = pk2(d2 * rs * gw4.z * pg8::silu_f(bflo(g[q].y)), d3 * rs * gw4.w * pg8::silu_f(bfhi(g[q].y)));
            *(u32x2*)(C.abuf() + (size_t)r * 1024 + 512 + 4 * lane) = o; }
        }
    }
}

#define XB_TMO      128
#define XB_XCNT(j)  (256  + 64 * (j))
#define XB_XSUB(j)  (1280 + 64 * (j))
#define XB_XGEN(j)  (2304 + 64 * (j))
#define XB_TOP      3328
#define XB_TOPGEN   3392
#define XCD_BAR_WORDS 3456
#define XB_SPIN_CAP (1u << 18)
__device__ __forceinline__ unsigned xb_ld(unsigned* p)              { return __hip_atomic_load(p, __ATOMIC_RELAXED, __HIP_MEMORY_SCOPE_AGENT); }
__device__ __forceinline__ unsigned xb_add(unsigned* p, unsigned v) { return __hip_atomic_fetch_add(p, v, __ATOMIC_RELAXED, __HIP_MEMORY_SCOPE_AGENT); }
__device__ __forceinline__ unsigned xb_xcc_id() { return (unsigned)__builtin_amdgcn_s_getreg((3 << 11) | 20) & 0xFu; }
#define XB_SPIN(cond, bar) do { unsigned _sp = 0; while (cond) { __builtin_amdgcn_s_sleep(1); \
    if ((++_sp & 255u) == 0u) { if (xb_ld(&(bar)[XB_TMO])) break; if (_sp > XB_SPIN_CAP) { atomicAdd(&(bar)[XB_TMO], 1u); break; } } } } while (0)
struct XcdBarrier { unsigned* bar; unsigned x; volatile LAS unsigned* st; };
__device__ __forceinline__ XcdBarrier xcd_barrier_post(unsigned* bar, volatile LAS unsigned* st) {
    XcdBarrier b; b.bar = bar; b.x = xb_xcc_id(); b.st = st;
    if (threadIdx.x == 0) (void)xb_add(&bar[XB_XCNT(b.x)], 1u);
    return b;
}
__device__ __forceinline__ void xcd_barrier_complete(unsigned* bar, unsigned x, unsigned& nloc, unsigned& nx) {
    const unsigned G = gridDim.x * gridDim.y * gridDim.z;
    unsigned sum, cnt, mine, sp = 0u;
    for (;;) {
        sum = 0u; cnt = 0u; mine = 0u;
#pragma unroll
        for (unsigned j = 0; j < 16; ++j) { const unsigned c = xb_ld(&bar[XB_XCNT(j)]); sum += c; cnt += (c > 0u) ? 1u : 0u; mine = (j == x) ? c : mine; }
        if (sum == G) break;
        __builtin_amdgcn_s_sleep(1);
        if ((++sp & 255u) == 0u) { if (xb_ld(&bar[XB_TMO])) break; if (sp > XB_SPIN_CAP) { atomicAdd(&bar[XB_TMO], 1u); break; } }
    }
    nloc = mine > 0u ? mine : 1u; nx = cnt > 0u ? cnt : 1u;
}
__device__ __forceinline__ void xcd_barrier(const XcdBarrier& b) {
    asm volatile("s_waitcnt vmcnt(0)" ::: "memory");
    __syncthreads();
    if (threadIdx.x == 0) {
        unsigned* bar = b.bar;
        __builtin_amdgcn_s_waitcnt(0);
        unsigned nloc = b.st[0], nx = b.st[1];
        if (nloc == 0u) { xcd_barrier_complete(bar, b.x, nloc, nx); b.st[0] = nloc; b.st[1] = nx; }
        const unsigned old = xb_add(&bar[XB_XSUB(b.x)], 1u);
        const unsigned gen = old / nloc;
        if (old + 1u == (gen + 1u) * nloc) {
            __builtin_amdgcn_fence(__ATOMIC_RELEASE, "agent");
            asm volatile("s_waitcnt vmcnt(0)" ::: "memory");
            const unsigned og = xb_add(&bar[XB_TOP], 1u);
            const unsigned tg = og / nx;
            if (og + 1u == (tg + 1u) * nx) xb_add(&bar[XB_TOPGEN], 1u);
            else XB_SPIN(xb_ld(&bar[XB_TOPGEN]) == tg, bar);
            __builtin_amdgcn_fence(__ATOMIC_ACQUIRE, "agent");
            xb_add(&bar[XB_XGEN(b.x)], 1u);
            asm volatile("s_waitcnt vmcnt(0)" ::: "memory");
        } else {
            XB_SPIN(xb_ld(&bar[XB_XGEN(b.x)]) == gen, bar);
            __builtin_amdgcn_fence(__ATOMIC_ACQUIRE, "agent");
            asm volatile("s_waitcnt vmcnt(0)" ::: "memory");
        }
    }
    __syncthreads();
}
constexpr int MISC_OFF = 141312;
constexpr size_t WS_BAR = 65536;

constexpr int NSUB = 9, NPHASE = 2 + NSUB * DEPTH;

__global__ void __launch_bounds__(NTHR) mk_fwd(Args args) {
    extern __shared__ __attribute__((aligned(16))) unsigned char lds_raw[];
    {
        LAS unsigned long long* ptab = (LAS unsigned long long*)((LAS unsigned char*)lds_raw + PT_OFF);
        if (threadIdx.x < 29) ptab[threadIdx.x] = (unsigned long long)args.in[threadIdx.x];
        if (threadIdx.x < 32) ((LAS unsigned*)((LAS unsigned char*)lds_raw + MISC_OFF))[threadIdx.x] = 0u;
        __syncthreads();
    }
    XcdBarrier xbar; xbar.bar = (unsigned*)(args.ws + WS_BAR); xbar.x = 0; xbar.st = nullptr;
    if (MK_SINGLE) xbar = xcd_barrier_post((unsigned*)(args.ws + WS_BAR), (volatile LAS unsigned*)((LAS unsigned char*)lds_raw + MISC_OFF) + 8);
    cg::grid_group grid = cg::this_grid();
    int probe_rep = 0;
    for (int ph = args.ph_lo; ph < args.ph_hi; ++ph) {
        Ctx C; C.lds = (LAS unsigned char*)lds_raw; C.G = gridDim.x; C.bid = blockIdx.x;
        { GAS unsigned char* ws_ = (GAS unsigned char*)args.ws; GAS float* out_ = (GAS float*)args.out; asm volatile("" : "+s"(ws_), "+s"(out_)); C.ws = (unsigned char*)ws_; C.out = (float*)out_; }
        if (ph == 0) phase_prologue(C);
        else if (ph == NPHASE - 1) phase_norm_b<1>(C, C.in(28), nullptr, 0, 0);
        else {
            const int layer = (ph - 1) / NSUB, sub = (ph - 1) % NSUB;
            const float* modl = C.mod() + (size_t)layer * 9 * 6144; bf16_t* wl = C.wts() + (size_t)layer * WL_TOTAL;
            switch (sub) {
            case 0: if (layer == 0) phase_norm<0>(C, C.in(0), C.in(1), C.in(10), modl, 0, 1024); else phase_norm_b<0>(C, C.in(10) + layer * DM, modl, 0, 1024); break;
            case 1: { pg8::Gemm g{C.abuf(), wl + WL_IN, NTOK, UP, DM}; pg8::StaticOrder S; S.init(NTOK, UP, C.G, C.bid); pg8::EpiBf16 E{C.ub(), UP};
                      pg8::gemm_phase<pg8::EpiBf16, pg8::StaticOrder, true, true>(C.lds, g, S, E);
                      if (layer == 0) {
                          const int rem = S.nwg % C.G; const bool all = rem == 0;
                          if (all || C.bid >= rem) { TIDS; (void)tid; __syncthreads(); convert_weights(C, 0, ((all ? C.bid : C.bid - rem)) * NWAVES + wave, (all ? C.G : C.G - rem) * NWAVES, wave, lane, 2); }
                      } } break;
            case 2: phase_prep(C, layer); break;
            case 3: phase_mixers(C, layer); break;
            case 4: phase_mix(C, layer); break;
            case 5: { pg8::Gemm g{C.abuf(), wl + WL_OUT, NTOK, DM, DM}; pg8::StaticOrder S; S.init(NTOK, DM, C.G, C.bid); pg8::EpiRes E{layer == 0 ? C.in(0) : nullptr, layer == 0 ? C.in(1) : nullptr, C.xb(), modl + 2048};
                      pg8::gemm_phase<pg8::EpiRes, pg8::StaticOrder, false, true>(C.lds, g, S, E); } break;
            case 6: phase_norm_b<0>(C, C.in(25) + layer * DM, modl, 3072, 4096); break;
            case 7: { pg8::Gemm g{C.abuf(), wl + WL_W1, NTOK, 2 * DFF, DM}; pg8::StaticOrder S; S.init(NTOK, 2 * DFF, C.G, C.bid); pg8::EpiSwiGLU E{C.ub(), DFF};
                      pg8::gemm_phase<pg8::EpiSwiGLU, pg8::StaticOrder, true, true>(C.lds, g, S, E);
                      if (layer + 1 < DEPTH) {
                          const int rem = S.nwg % C.G; const bool all = rem == 0;
                          if (all || C.bid >= rem) { TIDS; (void)tid; __syncthreads(); convert_weights(C, layer + 1, ((all ? C.bid : C.bid - rem)) * NWAVES + wave, (all ? C.G : C.G - rem) * NWAVES, wave, lane); }
                      } } break;
            case 8: { pg8::Gemm g{C.ub(), wl + WL_W2, NTOK, DM, DFF}; pg8::StaticOrder S; S.init(NTOK, DM, C.G, C.bid); pg8::EpiRes E{nullptr, nullptr, C.xb(), modl + 5120};
                      pg8::gemm_phase<pg8::EpiRes, pg8::StaticOrder, false, true>(C.lds, g, S, E); } break;
            }
        }
        if (ph + 1 < args.ph_hi) { if (args.ph_hi > 1000) grid.sync(); else xcd_barrier(xbar); }
        if (PROBE_SUB >= 0) { if (((ph > 0 && ph < NPHASE - 1 && (ph - 1) % NSUB == PROBE_SUB) || (PROBE_SUB == 100 && ph == 0)) && probe_rep == 0) { probe_rep = 1; --ph; } else probe_rep = 0; }
    }
}

extern "C" void kernel_launch(void* const* d_in, const int* in_sizes, int n_in, void* d_out, int out_size, void* d_ws, size_t ws_size, hipStream_t stream) {
    static int grid = 0;
    if (grid == 0) {
        if (n_in != 29 || ws_size < WS_END) { fprintf(stderr, "kernel_launch: unexpected inputs (n_in %d) or workspace %zu < %zu\n", n_in, ws_size, (size_t)WS_END); grid = -1; return; }
        int dev = 0, cus = 0, per_cu = 0;
        hipGetDevice(&dev); hipDeviceGetAttribute(&cus, hipDeviceAttributeMultiprocessorCount, dev);
        hipFuncSetAttribute((const void*)mk_fwd, hipFuncAttributeMaxDynamicSharedMemorySize, LDS_BYTES);
        hipOccupancyMaxActiveBlocksPerMultiprocessor(&per_cu, (const void*)mk_fwd, NTHR, LDS_BYTES);
        if (per_cu < 1) { fprintf(stderr, "kernel_launch: occupancy query says %d blocks per CU\n", per_cu); per_cu = 1; }
        (void)hipGetLastError();
        grid = cus * 1;
    }
    if (grid < 0) return;
    Args a{};
    for (int i = 0; i < 29; ++i) a.in[i] = (const float*)d_in[i];
    a.out = (float*)d_out; a.ws = (unsigned char*)d_ws;
#if MK_SINGLE
    if (hipMemsetAsync(d_ws, 0, 1u << 20, stream) != hipSuccess) { fprintf(stderr, "kernel_launch: memset failed\n"); return; }
    a.ph_lo = 0; a.ph_hi = NPHASE;
    void* kargs[] = {&a};
    hipError_t e = hipLaunchCooperativeKernel((const void*)mk_fwd, dim3(grid), dim3(NTHR), kargs, LDS_BYTES, stream);
    if (e != hipSuccess) fprintf(stderr, "cooperative launch failed: %s (grid %d)\n", hipGetErrorString(e), grid);
#else
    for (int ph = 0; ph < NPHASE; ++ph) { a.ph_lo = ph; a.ph_hi = ph + 1; hipLaunchKernelGGL(mk_fwd, dim3(grid), dim3(NTHR), LDS_BYTES, stream, a); }
#endif
}
```

```cpp
#include <hip/hip_runtime.h>
#include <hip/hip_cooperative_groups.h>
#include <cstdio>
#include <cstdint>
namespace cg = cooperative_groups;

#ifndef MK_SINGLE
#define MK_SINGLE 1
#endif

#ifndef PROBE_MIX
#define PROBE_MIX 0
#endif
#ifndef PROBE_NOX
#define PROBE_NOX 0
#endif
#ifndef PROBE_SUB
#define PROBE_SUB -1
#endif
#define LAS __attribute__((address_space(3)))
#define GAS __attribute__((address_space(1)))
typedef unsigned short bf16_t;
typedef short bf16x8 __attribute__((ext_vector_type(8)));
typedef float f32x4 __attribute__((ext_vector_type(4)));
typedef float f32x2 __attribute__((ext_vector_type(2)));
typedef unsigned u32x4 __attribute__((ext_vector_type(4)));
typedef unsigned u32x2 __attribute__((ext_vector_type(2)));

namespace pg8 {
constexpr int BM = 256, BK = 64, HALF = 128, HTB = HALF * BK * 2, STAGE_BYTES = 8 * HTB, NXCD = 8, WGM = 8;
__host__ __device__ __forceinline__ int lds_byte(int r, int c) { const int st = (r >> 4) * 2 + (c >> 5), rr = r & 15, cc = c & 31, ob = rr * 64 + cc * 2; return st * 1024 + (ob ^ (((ob >> 9) & 1) << 5)); }
__host__ __device__ __forceinline__ void stage_rc(int b, int& R, int& C) { const int st = b / 1024, sb = b % 1024, swz = sb ^ (((sb >> 9) & 1) << 5); R = (st >> 1) * 16 + swz / 64; C = (st & 1) * 32 + (swz % 64) / 2; }
__host__ __device__ __forceinline__ int perm32(int rho) { const int n = rho >> 4, i = rho & 15; return 8 * (i >> 2) + 4 * n + (i & 3); }

struct Unit { int pm, pn; };
struct Gemm { const bf16_t* A; const bf16_t* Bt; int M, N, K; };

struct StaticOrder {
    int nM, nN, nwg, G, c;
    __host__ __device__ void init(int M, int N, int G_, int c_) { nM = M / BM; nN = N / BM; nwg = nM * nN; G = G_; c = c_; }
    __host__ __device__ bool next(int i, Unit& u) const {
        const long L = (long)i * G + c; if (L >= nwg) return false;
        int wgid = (int)L; { const int q = nwg / NXCD, r = nwg % NXCD, xcd = wgid % NXCD, off = wgid / NXCD; wgid = (xcd < r ? xcd * (q + 1) : r * (q + 1) + (xcd - r) * q) + off; }
        const int nig = WGM * nN, gid = wgid / nig, fm = gid * WGM, gsz = (nM - fm) < WGM ? (nM - fm) : WGM;
        u.pm = fm + ((wgid % nig) % gsz); u.pn = (wgid % nig) / gsz; return true;
    }
    __device__ __forceinline__ void a_ready(const Unit&) const {}
    __device__ __forceinline__ void done(const Unit&) const {}
};

__device__ __forceinline__ void st16_wt(void* p, u32x4 v) { asm volatile("global_store_dwordx4 %0, %1, off sc1" :: "v"(p), "v"(v) : "memory"); }
__device__ __forceinline__ unsigned cvt_pk_bf16(float lo, float hi) { unsigned r; asm volatile("v_cvt_pk_bf16_f32 %0, %1, %2" : "=v"(r) : "v"(lo), "v"(hi)); return r; }

struct EpiBf16 {
    static constexpr bool PERM = true, AFTER_DRAIN = false;
    bf16_t* O; int ldc;
    __device__ __forceinline__ void operator()(const f32x4 (&acc)[2][2][4][2], const Unit& u, int wr, int wc, int fr_, int fq_) const {
        int fr = fr_, fq = fq_; asm volatile("" : "+v"(fr), "+v"(fq));
        const int row0 = u.pm * BM + wr * 64 + fr; const int col0 = u.pn * BM + wc * 32 + 8 * fq;
#pragma unroll
        for (int ai = 0; ai < 2; ++ai)
#pragma unroll
            for (int m = 0; m < 4; ++m) { bf16_t* rowp = O + (size_t)(row0 + ai * HALF + m * 16) * ldc + col0;
#pragma unroll
                for (int bj = 0; bj < 2; ++bj) { const f32x4 v0 = acc[ai][bj][m][0], v1 = acc[ai][bj][m][1];
                    u32x4 w; w.x = cvt_pk_bf16(v0[0], v0[1]); w.y = cvt_pk_bf16(v0[2], v0[3]); w.z = cvt_pk_bf16(v1[0], v1[1]); w.w = cvt_pk_bf16(v1[2], v1[3]);
                    st16_wt(rowp + bj * HALF, w); } }
    }
};
__device__ __forceinline__ float silu_f(float a) { return a * __builtin_amdgcn_rcpf(1.0f + __builtin_amdgcn_exp2f(-1.4426950408889634f * a)); }
struct EpiSwiGLU {
    static constexpr bool PERM = true, AFTER_DRAIN = false;
    bf16_t* O; int ldc;
    __device__ __forceinline__ void operator()(const f32x4 (&acc)[2][2][4][2], const Unit& u, int wr, int wc, int fr_, int fq_) const {
        int fr = fr_, fq = fq_; asm volatile("" : "+v"(fr), "+v"(fq));
        const int row0 = u.pm * BM + wr * 64 + fr; const int col0 = u.pn * HALF + wc * 32 + 8 * fq;
#pragma unroll
        for (int ai = 0; ai < 2; ++ai)
#pragma unroll
            for (int m = 0; m < 4; ++m) { bf16_t* rowp = O + (size_t)(row0 + ai * HALF + m * 16) * ldc + col0;
                const f32x4 a0 = acc[ai][0][m][0], a1 = acc[ai][0][m][1], g0 = acc[ai][1][m][0], g1 = acc[ai][1][m][1];
                u32x4 w;
                w.x = cvt_pk_bf16(silu_f(a0[0]) * g0[0], silu_f(a0[1]) * g0[1]); w.y = cvt_pk_bf16(silu_f(a0[2]) * g0[2], silu_f(a0[3]) * g0[3]);
                w.z = cvt_pk_bf16(silu_f(a1[0]) * g1[0], silu_f(a1[1]) * g1[1]); w.w = cvt_pk_bf16(silu_f(a1[2]) * g1[2], silu_f(a1[3]) * g1[3]);
                st16_wt(rowp, w); }
    }
};
struct EpiRes {
    static constexpr bool PERM = true, AFTER_DRAIN = false;
    const float* xin_lo; const float* xin_hi;
    bf16_t* xb; const float* gate;
    __device__ __forceinline__ void operator()(const f32x4 (&acc)[2][2][4][2], const Unit& u, int wr, int wc, int fr_, int fq_) const {
        int fr = fr_, fq = fq_; asm volatile("" : "+v"(fr), "+v"(fq));
        const int rt = u.pm * BM; const int cond = rt < 8192 ? 0 : 1 + ((rt - 8192) >> 10);
        const int col0 = u.pn * BM + wc * 32 + 8 * fq; const float* g = gate + cond * 6144 + col0;
        bf16_t* dst = xb + (size_t)rt * 1024 + col0;
        f32x4 gv[2][2];
#pragma unroll
        for (int bj = 0; bj < 2; ++bj)
#pragma unroll
            for (int n = 0; n < 2; ++n) gv[bj][n] = *(const f32x4*)(g + bj * HALF + 4 * n);
        if (xin_lo != nullptr) {
            const float* src = (rt < 8192 ? xin_lo + (size_t)rt * 1024 : xin_hi + (size_t)(rt - 8192) * 1024) + col0;
#pragma unroll
            for (int am = 0; am < 8; ++am) {
                const int ai = am >> 2, m = am & 3; const size_t off = (size_t)(ai * HALF + wr * 64 + m * 16 + fr) * 1024;
                f32x4 xv[2][2];
#pragma unroll
                for (int bj = 0; bj < 2; ++bj)
#pragma unroll
                    for (int n = 0; n < 2; ++n) xv[bj][n] = *(const f32x4*)(src + off + bj * HALF + 4 * n);
#pragma unroll
                for (int bj = 0; bj < 2; ++bj) { const f32x4 v0 = xv[bj][0] + gv[bj][0] * acc[ai][bj][m][0], v1 = xv[bj][1] + gv[bj][1] * acc[ai][bj][m][1];
                    u32x4 w; w.x = cvt_pk_bf16(v0[0], v0[1]); w.y = cvt_pk_bf16(v0[2], v0[3]); w.z = cvt_pk_bf16(v1[0], v1[1]); w.w = cvt_pk_bf16(v1[2], v1[3]);
                    *(u32x4*)(dst + off + bj * HALF) = w; }
            }
        } else {
#pragma unroll
            for (int ai = 0; ai < 2; ++ai) {
                u32x4 xv[4][2];
#pragma unroll
                for (int m = 0; m < 4; ++m) { const size_t off = (size_t)(ai * HALF + wr * 64 + m * 16 + fr) * 1024;
#pragma unroll
                    for (int bj = 0; bj < 2; ++bj) xv[m][bj] = *(const u32x4*)(dst + off + bj * HALF); }
#pragma unroll
                for (int m = 0; m < 4; ++m) { const size_t off = (size_t)(ai * HALF + wr * 64 + m * 16 + fr) * 1024;
#pragma unroll
                    for (int bj = 0; bj < 2; ++bj) { const u32x4 x = xv[m][bj];
                        const f32x4 x0 = (f32x4){__uint_as_float(x.x << 16), __uint_as_float(x.x & 0xffff0000u), __uint_as_float(x.y << 16), __uint_as_float(x.y & 0xffff0000u)};
                        const f32x4 x1 = (f32x4){__uint_as_float(x.z << 16), __uint_as_float(x.z & 0xffff0000u), __uint_as_float(x.w << 16), __uint_as_float(x.w & 0xffff0000u)};
                        const f32x4 v0 = x0 + gv[bj][0] * acc[ai][bj][m][0], v1 = x1 + gv[bj][1] * acc[ai][bj][m][1];
                        u32x4 w; w.x = cvt_pk_bf16(v0[0], v0[1]); w.y = cvt_pk_bf16(v0[2], v0[3]); w.z = cvt_pk_bf16(v1[0], v1[1]); w.w = cvt_pk_bf16(v1[2], v1[3]);
                        *(u32x4*)(dst + off + bj * HALF) = w; } }
            }
        }
    }
};

template <class Epi, class Sched, bool ALIGN_EPI = false, bool SP2 = false>
__device__ __forceinline__ void gemm_phase(LAS unsigned char* lds, const Gemm g, const Sched& S, const Epi& E) {
    int tid_ = threadIdx.x; asm volatile("" : "+v"(tid_));
    const int tid = tid_, wid = __builtin_amdgcn_readfirstlane(tid >> 6), lane = tid & 63, wr = wid >> 2, wc = wid & 3, fr = lane & 15, fq = lane >> 4;
    const int K = g.K, nt = K / BK;
    unsigned voffA[2], voffB[2];
#pragma unroll
    for (int i = 0; i < 2; ++i) { int R, C; stage_rc(tid * 16 + i * 8192, R, C); const int Rb = Epi::PERM ? ((R & ~31) + perm32(R & 31)) : R;
        voffA[i] = (unsigned)(R * K + C) * 2u; voffB[i] = (unsigned)(Rb * K + C) * 2u; }
    const size_t kstep = (size_t)(BK * 2);
    const size_t hstep = (size_t)HALF * K * 2;
    const size_t tstep = 2 * hstep;
    const unsigned ldsw = (unsigned)wid * 1024u;
    const int aoff = lds_byte(wr * 64 + fr, fq * 8), boff = lds_byte(wc * 32 + fr, fq * 8);
#define PG8_SA(b, h) (((b) * 2 + (h)) * HTB)
#define PG8_SB(b, h) ((4 + (b) * 2 + (h)) * HTB)
#define PG8_STAGE(bufoff, gbase, voff) do { _Pragma("unroll") for (int _i = 0; _i < 2; ++_i) \
        __builtin_amdgcn_global_load_lds((const unsigned*)((const char*)(gbase) + (voff)[_i]), (LAS unsigned*)(lds + (bufoff) + ldsw + _i * 8192), 16, 0, 0); } while (0)
#define PG8_LDA(dst, b, h) do { _Pragma("unroll") for (int m = 0; m < 4; ++m) _Pragma("unroll") for (int k = 0; k < 2; ++k) dst[m][k] = *(const LAS bf16x8*)(lds + PG8_SA(b, h) + aoff + m * 2048 + k * 1024); } while (0)
#define PG8_LDB(dst, b, h) do { _Pragma("unroll") for (int n = 0; n < 2; ++n) _Pragma("unroll") for (int k = 0; k < 2; ++k) dst[n][k] = *(const LAS bf16x8*)(lds + PG8_SB(b, h) + boff + n * 2048 + k * 1024); } while (0)
#define PG8_MMA(ai, bj, At, Bt) do { __builtin_amdgcn_s_setprio(1); _Pragma("unroll") for (int m = 0; m < 4; ++m) _Pragma("unroll") for (int n = 0; n < 2; ++n) _Pragma("unroll") for (int k = 0; k < 2; ++k) \
        acc[ai][bj][m][n] = __builtin_amdgcn_mfma_f32_16x16x32_bf16(Bt[n][k], At[m][k], acc[ai][bj][m][n], 0, 0, 0); __builtin_amdgcn_s_setprio(0); } while (0)
#define PG8_WAIT_V(n) asm volatile("s_waitcnt vmcnt(" #n ")" ::: "memory")
#define PG8_WAIT_L(n) asm volatile("s_waitcnt lgkmcnt(" #n ")" ::: "memory")
#define PG8_BAR __builtin_amdgcn_s_barrier()
#define PG8_SCHED __builtin_amdgcn_sched_barrier(0)
    Unit cur, nxt; int ui = 0;
    if (!S.next(0, cur)) return;
    f32x4 acc[2][2][4][2];
#pragma unroll
    for (int a = 0; a < 2; ++a)
#pragma unroll
        for (int b = 0; b < 2; ++b)
#pragma unroll
            for (int m = 0; m < 4; ++m)
#pragma unroll
                for (int n = 0; n < 2; ++n) acc[a][b][m][n] = (f32x4){0.f, 0.f, 0.f, 0.f};
    bf16x8 At[4][2], B0[2][2], B1[2][2];
    const char* cA = (const char*)g.A + (size_t)cur.pm * tstep; const char* cB = (const char*)g.Bt + (size_t)cur.pn * tstep;
    S.a_ready(cur);
    if constexpr (SP2) {
        PG8_STAGE(PG8_SB(0, 0), cB, voffB); PG8_STAGE(PG8_SB(0, 1), cB + hstep, voffB); PG8_STAGE(PG8_SA(0, 0), cA, voffA); PG8_STAGE(PG8_SA(0, 1), cA + hstep, voffA);
        if (wr == 1) PG8_BAR;
        PG8_WAIT_V(2); PG8_BAR;
        PG8_STAGE(PG8_SB(1, 0), cB + kstep, voffB); PG8_STAGE(PG8_SA(1, 0), cA + kstep, voffA); PG8_STAGE(PG8_SB(1, 1), cB + hstep + kstep, voffB);
        PG8_WAIT_V(6); PG8_BAR;
    } else {
        PG8_STAGE(PG8_SB(0, 0), cB, voffB); PG8_STAGE(PG8_SA(0, 0), cA, voffA); PG8_STAGE(PG8_SB(0, 1), cB + hstep, voffB); PG8_STAGE(PG8_SA(0, 1), cA + hstep, voffA);
        if (wr == 1) PG8_BAR;
        PG8_WAIT_V(4); PG8_BAR;
        PG8_STAGE(PG8_SB(1, 0), cB + kstep, voffB); PG8_STAGE(PG8_SA(1, 0), cA + kstep, voffA); PG8_STAGE(PG8_SB(1, 1), cB + hstep + kstep, voffB);
        PG8_WAIT_V(6); PG8_BAR;
    }
    for (;;) {
        const bool has_next = S.next(ui + 1, nxt);
        const char* nA = has_next ? (const char*)g.A + (size_t)nxt.pm * tstep : cA; const char* nB = has_next ? (const char*)g.Bt + (size_t)nxt.pn * tstep : cB;
        for (int t = 0; t < nt; t += 2) {
            const bool last = (t == nt - 2);
            const char* a1 = cA + (size_t)(t + 1) * kstep;
            const char* a2 = last ? nA : cA + (size_t)(t + 2) * kstep; const char* b2 = last ? nB : cB + (size_t)(t + 2) * kstep;
            const char* a3 = a2 + kstep; const char* b3 = b2 + kstep;
            if (last && has_next) S.a_ready(nxt);
            if constexpr (SP2) {
            PG8_LDB(B0, 0, 0); PG8_LDB(B1, 0, 1); PG8_SCHED; PG8_LDA(At, 0, 0); PG8_STAGE(PG8_SA(1, 1), a1 + hstep, voffA);
            PG8_WAIT_V(8); PG8_WAIT_L(0); PG8_BAR; PG8_MMA(0, 0, At, B0); PG8_MMA(0, 1, At, B1); PG8_BAR; PG8_SCHED;
            PG8_LDA(At, 0, 1); PG8_STAGE(PG8_SB(0, 0), b2, voffB); PG8_STAGE(PG8_SB(0, 1), b2 + hstep, voffB); PG8_STAGE(PG8_SA(0, 0), a2, voffA);
            PG8_WAIT_V(8); PG8_WAIT_L(0); PG8_BAR; PG8_MMA(1, 0, At, B0); PG8_MMA(1, 1, At, B1); PG8_BAR; PG8_SCHED;
            PG8_LDB(B0, 1, 0); PG8_LDB(B1, 1, 1); PG8_SCHED; PG8_LDA(At, 1, 0); PG8_STAGE(PG8_SA(0, 1), a2 + hstep, voffA);
            PG8_WAIT_V(8); PG8_WAIT_L(0); PG8_BAR; PG8_MMA(0, 0, At, B0); PG8_MMA(0, 1, At, B1); PG8_BAR; PG8_SCHED;
            PG8_LDA(At, 1, 1); PG8_STAGE(PG8_SB(1, 0), b3, voffB); PG8_STAGE(PG8_SB(1, 1), b3 + hstep, voffB); PG8_STAGE(PG8_SA(1, 0), a3, voffA);
            PG8_WAIT_V(8); PG8_WAIT_L(0); PG8_BAR; PG8_MMA(1, 0, At, B0); PG8_MMA(1, 1, At, B1); PG8_BAR; PG8_SCHED;
            } else {
            PG8_LDB(B0, 0, 0); PG8_SCHED; PG8_LDA(At, 0, 0); PG8_STAGE(PG8_SA(1, 1), a1 + hstep, voffA);
            PG8_WAIT_L(8); PG8_BAR; PG8_WAIT_L(0); PG8_MMA(0, 0, At, B0); PG8_BAR; PG8_SCHED;
            PG8_LDB(B1, 0, 1); PG8_STAGE(PG8_SB(0, 0), b2, voffB);
            PG8_BAR; PG8_WAIT_L(0); PG8_MMA(0, 1, At, B1); PG8_BAR;
            PG8_LDA(At, 0, 1); PG8_STAGE(PG8_SA(0, 0), a2, voffA);
            PG8_BAR; PG8_WAIT_L(0); PG8_MMA(1, 0, At, B0); PG8_BAR; PG8_SCHED;
            PG8_STAGE(PG8_SB(0, 1), b2 + hstep, voffB);
            PG8_WAIT_V(6); PG8_BAR; PG8_MMA(1, 1, At, B1); PG8_BAR;
            PG8_LDB(B0, 1, 0); PG8_SCHED; PG8_LDA(At, 1, 0); PG8_STAGE(PG8_SA(0, 1), a2 + hstep, voffA);
            PG8_WAIT_L(8); PG8_BAR; PG8_WAIT_L(0); PG8_MMA(0, 0, At, B0); PG8_BAR; PG8_SCHED;
            PG8_LDB(B1, 1, 1); PG8_STAGE(PG8_SB(1, 0), b3, voffB);
            PG8_BAR; PG8_WAIT_L(0); PG8_MMA(0, 1, At, B1); PG8_BAR;
            PG8_LDA(At, 1, 1); PG8_STAGE(PG8_SA(1, 0), a3, voffA);
            PG8_BAR; PG8_WAIT_L(0); PG8_MMA(1, 0, At, B0); PG8_BAR; PG8_SCHED;
            PG8_STAGE(PG8_SB(1, 1), b3 + hstep, voffB);
            PG8_WAIT_V(6); PG8_BAR; PG8_MMA(1, 1, At, B1); PG8_BAR;
            }
        }
        if constexpr (ALIGN_EPI) { if (wr == 0) PG8_BAR; }
        if constexpr (!Epi::AFTER_DRAIN) { E(acc, cur, wr, wc, fr, fq); S.done(cur); }
        if (!has_next) break;
#pragma unroll
        for (int a = 0; a < 2; ++a)
#pragma unroll
            for (int b = 0; b < 2; ++b)
#pragma unroll
                for (int m = 0; m < 4; ++m)
#pragma unroll
                    for (int n = 0; n < 2; ++n) acc[a][b][m][n] = (f32x4){0.f, 0.f, 0.f, 0.f};
        cur = nxt; cA = nA; cB = nB; ++ui;
        if constexpr (ALIGN_EPI) { if (wr == 1) PG8_BAR; }
    }
    PG8_WAIT_V(0);
    if constexpr (!ALIGN_EPI) { if (wr == 0) PG8_BAR; }
    PG8_BAR;
#undef PG8_SA
#undef PG8_SB
#undef PG8_STAGE
#undef PG8_LDA
#undef PG8_LDB
#undef PG8_MMA
#undef PG8_WAIT_V
#undef PG8_WAIT_L
#undef PG8_BAR
#undef PG8_SCHED
}
}

constexpr int NWAVES = 8, NTHR = 512;
constexpr int DM = 1024, NTOK = 16384, NCTXR = 8192, DEPTH = 4;
constexpr int UP = 2816;
constexpr int DFF = 2816;
constexpr int U_XBC = 512, U_DT = 1280, U_RQ = 1296, U_RK = 1552, U_RV = 1808, U_RG = 2064, U_MQ = 2320, U_MKV = 2576, U_MKR = 2704;
constexpr int KVROWS = 8192 + 8 * 1536;
constexpr float EPS = 1e-6f;
constexpr int LDS_BYTES = 147456;

constexpr size_t MiB = 1u << 20;
constexpr size_t WS_MOD = 1 * MiB, WS_ROPE = 2 * MiB, WS_DT = 3 * MiB, WS_LA = 4 * MiB, WS_KR = 5 * MiB, WS_CKV = 7 * MiB, WS_QC = 12 * MiB,
                 WS_Q = 20 * MiB, WS_KV = 36 * MiB, WS_XBC = 56 * MiB, WS_YSSD = 80 * MiB, WS_YRET = 112 * MiB, WS_ABUF = 128 * MiB, WS_U = 160 * MiB, WS_W = 248 * MiB;
constexpr size_t WL_IN = 0, WL_OUT = WL_IN + (size_t)UP * 1024, WL_W1 = WL_OUT + 1024 * 1024, WL_W2 = WL_W1 + (size_t)5632 * 1024, WL_UQ = WL_W2 + (size_t)1024 * 2816,
                 WL_UKV = WL_UQ + 512 * 256, WL_TOTAL = WL_UKV + 512 * 128;
constexpr size_t WS_XB = 348 * MiB;
constexpr size_t WS_END = 380 * MiB;
static_assert(WS_W + 4 * WL_TOTAL * 2 <= WS_XB, "d_ws map");

constexpr size_t O_YP = 0, O_YS = 8388608, O_SSD = 16777216, O_RET = 25165824, O_CKV = 29360128, O_KR = 33554432;

struct Args { const float* in[29]; float* out; unsigned char* ws; int ph_lo, ph_hi; };

constexpr int PT_OFF = 140288;
__device__ __forceinline__ int fresh_tid() { int t = threadIdx.x; asm volatile("" : "+v"(t)); return t; }
#define TIDS const int tid = fresh_tid(), lane = tid & 63, wave = __builtin_amdgcn_readfirstlane(tid >> 6)
struct Ctx {
    LAS unsigned char* lds; int G, bid; float* out; unsigned char* ws;
    __device__ __forceinline__ const float* in(int k) const { const u32x2 v = *(const LAS u32x2*)(lds + PT_OFF + 8 * k);
        const unsigned lo = __builtin_amdgcn_readfirstlane(v.x), hi = __builtin_amdgcn_readfirstlane(v.y); return (const float*)(const GAS float*)(((unsigned long long)hi << 32) | lo); }
    __device__ __forceinline__ float* mod() const { return (float*)(ws + WS_MOD); }
    __device__ __forceinline__ float* ropec() const { return (float*)(ws + WS_ROPE); }
    __device__ __forceinline__ float* ropes() const { return (float*)(ws + WS_ROPE) + 1024 * 32; }
    __device__ __forceinline__ float* dtb() const { return (float*)(ws + WS_DT); }
    __device__ __forceinline__ float* lab() const { return (float*)(ws + WS_LA); }
    __device__ __forceinline__ bf16_t* krall() const { return (bf16_t*)(ws + WS_KR); }
    __device__ __forceinline__ bf16_t* ckvall() const { return (bf16_t*)(ws + WS_CKV); }
    __device__ __forceinline__ bf16_t* qc() const { return (bf16_t*)(ws + WS_QC); }
    __device__ __forceinline__ bf16_t* qb() const { return (bf16_t*)(ws + WS_Q); }
    __device__ __forceinline__ bf16_t* kvb() const { return (bf16_t*)(ws + WS_KV); }
    __device__ __forceinline__ bf16_t* xbc() const { return (bf16_t*)(ws + WS_XBC); }
    __device__ __forceinline__ bf16_t* yssd() const { return (bf16_t*)(ws + WS_YSSD); }
    __device__ __forceinline__ bf16_t* yret() const { return (bf16_t*)(ws + WS_YRET); }
    __device__ __forceinline__ bf16_t* abuf() const { return (bf16_t*)(ws + WS_ABUF); }
    __device__ __forceinline__ bf16_t* ub() const { return (bf16_t*)(ws + WS_U); }
    __device__ __forceinline__ bf16_t* wts() const { return (bf16_t*)(ws + WS_W); }
    __device__ __forceinline__ bf16_t* xb() const { return (bf16_t*)(ws + WS_XB); }
};

__device__ __forceinline__ float bf2f(unsigned v) { return __uint_as_float(v << 16); }
__device__ __forceinline__ float bflo(unsigned w) { return __uint_as_float(w << 16); }
__device__ __forceinline__ float bfhi(unsigned w) { return __uint_as_float(w & 0xffff0000u); }
__device__ __forceinline__ unsigned pk2(float lo, float hi) { return pg8::cvt_pk_bf16(lo, hi); }
template <int CTRL> __device__ __forceinline__ float dppf(float v) { return __builtin_bit_cast(float, __builtin_amdgcn_update_dpp(0, __builtin_bit_cast(int, v), CTRL, 0xf, 0xf, false)); }
__device__ __forceinline__ float row16_sum(float v) { v += dppf<0x128>(v); v += dppf<0x124>(v); v += dppf<0x122>(v); v += dppf<0x121>(v); return v; }
__device__ __forceinline__ float rlane(float v, int l) { return __builtin_bit_cast(float, __builtin_amdgcn_readlane(__builtin_bit_cast(int, v), l)); }
__device__ __forceinline__ float wave_sum(float v) { v = row16_sum(v); return (rlane(v, 0) + rlane(v, 16)) + (rlane(v, 32) + rlane(v, 48)); }
__device__ __forceinline__ int cond_of_row(int r) { return r < NCTXR ? 0 : 1 + ((r - NCTXR) >> 10); }
__device__ __forceinline__ int xcd_tile(int bid) { return (bid & 7) * 32 + (bid >> 3); }
__device__ __forceinline__ int xcd_row(int v, int G) { if (G != 256) return v; const int bid = (v & 2047) >> 3; return xcd_tile(bid) * 64 + (v >> 11) * 8 + (v & 7); }


template <int MODE>
__device__ __forceinline__ void transpose_item(const float* W, int K, int N, bf16_t* WT, LAS float* scr, int item, int lane, int nblk) {
    const int kb = item / nblk, nb = item % nblk, k0 = 64 * kb, n0 = 32 * nb;
    const int ks = lane >> 3, ns = lane & 7, nn = n0 + 4 * ns; const bool ok = nn < N;
    f32x4 v[8];
#pragma unroll
    for (int i = 0; i < 8; ++i) v[i] = ok ? __builtin_nontemporal_load((const f32x4*)(W + (size_t)(k0 + i * 8 + ks) * N + nn)) : (f32x4){0.f, 0.f, 0.f, 0.f};
#pragma unroll
    for (int i = 0; i < 8; ++i) { LAS float* d = scr + (i * 8 + ks) * 33 + 4 * ns; d[0] = v[i].x; d[1] = v[i].y; d[2] = v[i].z; d[3] = v[i].w; }
    asm volatile("s_waitcnt lgkmcnt(0)" ::: "memory");
    const int c = lane & 7;
#pragma unroll
    for (int j = 0; j < 4; ++j) { const int nl = (lane >> 3) + 8 * j; const int n = n0 + nl; const LAS float* s = scr + (8 * c) * 33 + nl;
        int row = n;
        if (MODE == 1) { const int jj = n < 2816 ? n : n - 2816; row = 256 * (jj >> 7) + (jj & 127) + (n < 2816 ? 0 : 128); }
        u32x4 o; o.x = pk2(s[0 * 33], s[1 * 33]); o.y = pk2(s[2 * 33], s[3 * 33]); o.z = pk2(s[4 * 33], s[5 * 33]); o.w = pk2(s[6 * 33], s[7 * 33]);
        *(u32x4*)(WT + (size_t)row * K + k0 + 8 * c) = o; }
    asm volatile("s_waitcnt lgkmcnt(0)" ::: "memory");
}

__device__ __forceinline__ void convert_weights(Ctx& C, int l, int widx, int nw, int wave, int lane, int which = 0) {
    LAS float* scr = (LAS float*)(C.lds + wave * 8448);
    constexpr int I_IN = 16 * 88, I_OUT = 16 * 32, I_W1 = 16 * 176, I_W2 = 44 * 32, I_UQ = 4 * 16, I_UKV = 2 * 16, I_L = I_IN + I_OUT + I_W1 + I_W2 + I_UQ + I_UKV;
    bf16_t* wl = C.wts() + (size_t)l * WL_TOTAL;
    for (int it = widx; it < I_L; it += nw) {
        int r = it;
        { const bool late = r >= I_IN && r < I_IN + I_OUT + I_W1 + I_W2; if ((which == 1 && late) || (which == 2 && !late)) continue; }
        if (r < I_IN) { transpose_item<0>(C.in(11) + (size_t)l * 1024 * 2736, 1024, 2736, wl + WL_IN, scr, r, lane, 88); continue; } r -= I_IN;
        if (r < I_OUT) { transpose_item<0>(C.in(24) + (size_t)l * 1024 * 1024, 1024, 1024, wl + WL_OUT, scr, r, lane, 32); continue; } r -= I_OUT;
        if (r < I_W1) { transpose_item<1>(C.in(26) + (size_t)l * 1024 * 5632, 1024, 5632, wl + WL_W1, scr, r, lane, 176); continue; } r -= I_W1;
        if (r < I_W2) { transpose_item<0>(C.in(27) + (size_t)l * 2816 * 1024, 2816, 1024, wl + WL_W2, scr, r, lane, 32); continue; } r -= I_W2;
        if (r < I_UQ) { transpose_item<0>(C.in(21) + (size_t)l * 256 * 384, 256, 384, wl + WL_UQ, scr, r, lane, 16); continue; } r -= I_UQ;
        transpose_item<0>(C.in(23) + (size_t)l * 128 * 512, 128, 512, wl + WL_UKV, scr, r, lane, 16);
    }
}

__device__ __forceinline__ void phase_prologue(Ctx& C) {
    TIDS;
    for (int i = C.bid * NTHR + tid; i < 1024 * 32; i += C.G * NTHR) {
        const int t = i >> 5, d = i & 31, i8 = d & 7; const float pos = (float)((d < 16) ? (t >> 6) : (t & 63));
        const float inv = exp2f(-(float)i8 * 0.125f * 13.287712379549449f);
        const float ang = pos * inv;
        const float k = rintf(ang * 0.15915494309189535f);
        float rr = fmaf(-k, 6.28125f, ang); rr = fmaf(-k, 1.9353071795864769e-3f, rr);
        C.ropec()[i] = cosf(rr); C.ropes()[i] = sinf(rr);
    }
    if (C.bid < 192) {
        LAS float* sc = (LAS float*)(C.lds);
        LAS float* red = (LAS float*)(C.lds + 36 * 1024);
        const float* cctx = C.in(7); const float* cc = C.in(2);
        for (int i = tid; i < 9 * 1024; i += NTHR) { const int cnd = i >> 10, k = i & 1023; const float v = cnd == 0 ? cctx[k] : cc[(cnd - 1) * 1024 + k]; sc[i] = v / (1.0f + __expf(-v)); }
        __syncthreads();
        for (int task = C.bid; task < 192; task += C.G) {
            const int l = task / 48, col0 = (task % 48) * 128;
            const float* W = C.in(8) + (size_t)l * 1024 * 6144 + col0 + 2 * lane + (size_t)(wave * 128) * 6144;
            f32x2 a[9];
#pragma unroll
            for (int q = 0; q < 9; ++q) a[q] = (f32x2){0.f, 0.f};
            for (int k8 = 0; k8 < 128; k8 += 8) {
                f32x2 w[8];
#pragma unroll
                for (int e = 0; e < 8; ++e) w[e] = __builtin_nontemporal_load((const f32x2*)(W + (size_t)(k8 + e) * 6144));
#pragma unroll
                for (int q = 0; q < 9; ++q) { const f32x4 s0 = *(const LAS f32x4*)(sc + q * 1024 + wave * 128 + k8), s1 = *(const LAS f32x4*)(sc + q * 1024 + wave * 128 + k8 + 4);
                    a[q] += w[0] * s0.x; a[q] += w[1] * s0.y; a[q] += w[2] * s0.z; a[q] += w[3] * s0.w; a[q] += w[4] * s1.x; a[q] += w[5] * s1.y; a[q] += w[6] * s1.z; a[q] += w[7] * s1.w; }
            }
#pragma unroll
            for (int q = 0; q < 9; ++q) *(LAS f32x2*)(red + (wave * 9 + q) * 128 + 2 * lane) = a[q];
            __syncthreads();
            const float* bada = C.in(9);
            for (int o = tid; o < 9 * 128; o += NTHR) { const int q = o >> 7, c = o & 127; float sum = 0.f;
#pragma unroll
                for (int z = 0; z < 8; ++z) sum += red[(z * 9 + q) * 128 + c];
                C.mod()[((size_t)l * 9 + q) * 6144 + col0 + c] = sum + bada[(size_t)l * 6144 + col0 + c]; }
            __syncthreads();
        }
    }
    __syncthreads();
    convert_weights(C, 0, C.bid * NWAVES + wave, C.G * NWAVES, wave, lane, 1);
}

template <int MODE>
__device__ __forceinline__ void phase_norm(Ctx& C, const float* xlo, const float* xhi, const float* w, const float* modl, int sh_off, int sc_off) {
    TIDS;
    const int gw = C.bid * NWAVES + wave, NGW = C.G * NWAVES;
    f32x4 wv[4];
#pragma unroll
    for (int j = 0; j < 4; ++j) wv[j] = *(const f32x4*)(w + 4 * lane + 256 * j);
    for (int r0 = gw; r0 < NTOK; r0 += 2 * NGW) {
        f32x4 v[2][4]; int rr[2];
#pragma unroll
        for (int q = 0; q < 2; ++q) { const int r = xcd_row(r0 + q * NGW < NTOK ? r0 + q * NGW : r0, C.G); rr[q] = r;
            const float* xr = r < NCTXR ? xlo + (size_t)r * DM : xhi + (size_t)(r - NCTXR) * DM;
#pragma unroll
            for (int j = 0; j < 4; ++j) v[q][j] = *(const f32x4*)(xr + 4 * lane + 256 * j); }
#pragma unroll
        for (int q = 0; q < 2; ++q) { const int r = rr[q]; float s = 0.f;
#pragma unroll
            for (int j = 0; j < 4; ++j) s += (v[q][j].x * v[q][j].x + v[q][j].y * v[q][j].y) + (v[q][j].z * v[q][j].z + v[q][j].w * v[q][j].w);
            const float rstd = rsqrtf(wave_sum(s) * (1.f / DM) + EPS);
            if (MODE == 0) {
                const float* m = modl + cond_of_row(r) * 6144;
#pragma unroll
                for (int j = 0; j < 4; ++j) { const int c = 4 * lane + 256 * j; const f32x4 scv = *(const f32x4*)(m + sc_off + c), shv = *(const f32x4*)(m + sh_off + c);
                    const f32x4 h = v[q][j] * rstd * wv[j] * (scv + 1.0f) + shv;
                    u32x2 o; o.x = pk2(h.x, h.y); o.y = pk2(h.z, h.w); *(u32x2*)(C.abuf() + (size_t)r * DM + c) = o; }
            } else {
#pragma unroll
                for (int j = 0; j < 4; ++j) { const int c = 4 * lane + 256 * j; *(f32x4*)(C.out + (size_t)r * DM + c) = v[q][j] * rstd * wv[j]; }
            }
        }
    }
}

template <int MODE>
__device__ __forceinline__ void phase_norm_b(Ctx& C, const float* w, const float* modl, int sh_off, int sc_off) {
    TIDS;
    const int gw = C.bid * NWAVES + wave, NGW = C.G * NWAVES;
    f32x4 wv[2][2];
#pragma unroll
    for (int j = 0; j < 2; ++j) { wv[j][0] = *(const f32x4*)(w + 8 * lane + 512 * j); wv[j][1] = *(const f32x4*)(w + 8 * lane + 512 * j + 4); }
    for (int r0 = gw; r0 < NTOK; r0 += 4 * NGW) {
        u32x4 raw[4][2]; int rr[4];
#pragma unroll
        for (int q = 0; q < 4; ++q) { const int r = xcd_row(r0 + q * NGW < NTOK ? r0 + q * NGW : r0, C.G); rr[q] = r;
#pragma unroll
            for (int j = 0; j < 2; ++j) raw[q][j] = *(const u32x4*)(C.xb() + (size_t)r * DM + 8 * lane + 512 * j); }
#pragma unroll
        for (int q = 0; q < 4; ++q) { const int r = rr[q]; f32x4 v[2][2]; float s = 0.f;
#pragma unroll
            for (int j = 0; j < 2; ++j) { const u32x4 x = raw[q][j]; v[j][0] = (f32x4){bflo(x.x), bfhi(x.x), bflo(x.y), bfhi(x.y)}; v[j][1] = (f32x4){bflo(x.z), bfhi(x.z), bflo(x.w), bfhi(x.w)};
#pragma unroll
                for (int hh = 0; hh < 2; ++hh) s += (v[j][hh].x * v[j][hh].x + v[j][hh].y * v[j][hh].y) + (v[j][hh].z * v[j][hh].z + v[j][hh].w * v[j][hh].w); }
            const float rstd = rsqrtf(wave_sum(s) * (1.f / DM) + EPS);
            if (MODE == 0) {
                const float* m = modl + cond_of_row(r) * 6144;
#pragma unroll
                for (int j = 0; j < 2; ++j) { const int c = 8 * lane + 512 * j; f32x4 h[2];
#pragma unroll
                    for (int hh = 0; hh < 2; ++hh) { const f32x4 scv = *(const f32x4*)(m + sc_off + c + 4 * hh), shv = *(const f32x4*)(m + sh_off + c + 4 * hh); h[hh] = v[j][hh] * rstd * wv[j][hh] * (scv + 1.0f) + shv; }
                    u32x4 o; o.x = pk2(h[0].x, h[0].y); o.y = pk2(h[0].z, h[0].w); o.z = pk2(h[1].x, h[1].y); o.w = pk2(h[1].z, h[1].w); *(u32x4*)(C.abuf() + (size_t)r * DM + c) = o; }
            } else {
#pragma unroll
                for (int j = 0; j < 2; ++j) { const int c = 8 * lane + 512 * j;
#pragma unroll
                    for (int hh = 0; hh < 2; ++hh) *(f32x4*)(C.out + (size_t)r * DM + c + 4 * hh) = v[j][hh] * rstd * wv[j][hh]; }
            }
        }
    }
}

#define MFMA16P(x, y, c) __builtin_amdgcn_mfma_f32_16x16x32_bf16((x), (y), (c), 0, 0, 0)
constexpr int PP_QC = 0, PP_CKV = 33792;
__device__ __forceinline__ void phase_prep(Ctx& C, int layer) {
    TIDS; const int fr = lane & 15, fq = lane >> 4;
    LAS bf16_t* sQC = (LAS bf16_t*)(C.lds + PP_QC); LAS bf16_t* sCKV = (LAS bf16_t*)(C.lds + PP_CKV);
    const float* cw = C.in(12) + (size_t)layer * 5 * 768; const float* cb = C.in(13) + (size_t)layer * 768;
    const f32x4 qnw = *(const f32x4*)(C.in(20) + layer * 256 + 4 * lane); const f32x2 kvnw = *(const f32x2*)(C.in(22) + layer * 128 + 2 * lane);
    const float dtbias = C.in(14)[layer * 16 + (lane & 15)], aexp = __expf(C.in(15)[layer * 16 + (lane & 15)]);
    const bf16_t* wl = C.wts() + (size_t)layer * WL_TOTAL;
    for (int tile_ = C.bid; tile_ < NTOK / 64; tile_ += C.G) { const int tile = C.G == 256 ? xcd_tile(tile_) : tile_;
        __syncthreads();
        f32x2 cv[2], ck[2];
#pragma unroll
        for (int q = 0; q < 2; ++q) { const int idx = 16 * tile + 2 * wave + q, b = idx >> 9, sx = idx & 511;
            cv[q] = *(const f32x2*)(C.in(5) + (((size_t)b * DEPTH + layer) * 512 + sx) * 128 + 2 * lane);
            ck[q] = *(const f32x2*)(C.in(6) + (((size_t)b * DEPTH + layer) * 512 + sx) * 32 + 2 * (lane & 15)); }
        const int r0 = tile * 64 + wave * 8; const bool ctx = r0 < NCTXR; const int b = ctx ? (r0 >> 8) : ((r0 - NCTXR) >> 10), t0 = ctx ? (r0 & 255) : ((r0 - NCTXR) & 1023), L = ctx ? 256 : 1024;
        const bf16_t* u0 = C.ub() + (size_t)r0 * UP;
        unsigned rdt[8]; u32x2 rq[8]; unsigned rkv[8]; unsigned rkr[8];
#pragma unroll
        for (int j = 0; j < 8; ++j) { const bf16_t* ur = u0 + (size_t)j * UP; rdt[j] = ur[U_DT + (lane & 15)]; rq[j] = *(const u32x2*)(ur + U_MQ + 4 * lane); rkv[j] = *(const unsigned*)(ur + U_MKV + 2 * lane); rkr[j] = ur[U_MKR + (lane & 31)]; }
        {
            int lane_ = lane; asm volatile("" : "+v"(lane_)); const int lane = lane_;
            u32x2 raw[12][3];
#pragma unroll
            for (int j = 0; j < 12; ++j) { const int tt = t0 + j - 2; const bool ok = tt >= 0 && tt < L;
#pragma unroll
                for (int c3 = 0; c3 < 3; ++c3) raw[j][c3] = ok ? *(const u32x2*)((u0 - 2 * UP) + (unsigned)(j * UP + U_XBC + 4 * lane + 256 * c3)) : (u32x2){0u, 0u}; }
#pragma unroll
            for (int c3 = 0; c3 < 3; ++c3) { const unsigned ch = 4 * lane + 256 * c3; const f32x4 bias = *(const f32x4*)(cb + ch); f32x4 wv[5];
#pragma unroll
                for (int w = 0; w < 5; ++w) wv[w] = *(const f32x4*)(cw + (w * 768u + ch));
#pragma unroll
                for (int j = 0; j < 8; ++j) { f32x4 acc = bias;
#pragma unroll
                    for (int w = 0; w < 5; ++w) { const u32x2 rw = raw[j + w][c3]; acc.x += bflo(rw.x) * wv[w].x; acc.y += bfhi(rw.x) * wv[w].y; acc.z += bflo(rw.y) * wv[w].z; acc.w += bfhi(rw.y) * wv[w].w; }
                    u32x2 o; o.x = pk2(pg8::silu_f(acc.x), pg8::silu_f(acc.y)); o.y = pk2(pg8::silu_f(acc.z), pg8::silu_f(acc.w)); *(u32x2*)((C.xbc() + (size_t)(r0 + j) * 768) + ch) = o; } }
        }
        { int lane_ = lane; asm volatile("" : "+v"(lane_)); const int lane = lane_;
#pragma unroll
        for (int q = 0; q < 2; ++q) { const int idx = 16 * tile + 2 * wave + q, b = idx >> 9, sx = idx & 511; const size_t krow = 8192 + (size_t)b * 1536 + sx;
            *(LAS unsigned*)(sCKV + (64 + 2 * wave + q) * 136 + 2 * lane) = pk2(cv[q].x, cv[q].y);
            if (lane < 16) *(unsigned*)(C.krall() + krow * 32 + 2 * lane) = pk2(ck[q].x, ck[q].y); }
#pragma unroll
        for (int j = 0; j < 8; ++j) { const int r = r0 + j, t = t0 + j;
            if (lane < 16) { const float v = bf2f(rdt[j]) + dtbias; const float dt = v > 20.f ? v : 0.6931471805599453f * __builtin_amdgcn_logf(1.0f + __builtin_amdgcn_exp2f(1.4426950408889634f * v)); C.dtb()[(size_t)r * 16 + lane] = dt; C.lab()[(size_t)r * 16 + lane] = -dt * aexp; }
            { const float x0 = bflo(rq[j].x), x1 = bfhi(rq[j].x), x2 = bflo(rq[j].y), x3 = bfhi(rq[j].y);
              const float rstd = rsqrtf(wave_sum(x0 * x0 + x1 * x1 + x2 * x2 + x3 * x3) * (1.f / 256) + EPS);
              u32x2 o; o.x = pk2(x0 * rstd * qnw.x, x1 * rstd * qnw.y); o.y = pk2(x2 * rstd * qnw.z, x3 * rstd * qnw.w); *(LAS u32x2*)(sQC + (wave * 8 + j) * 264 + 4 * lane) = o; }
            const size_t krow = ctx ? (size_t)r : 8192 + (size_t)b * 1536 + 512 + t;
            { const float x0 = bflo(rkv[j]), x1 = bfhi(rkv[j]); const float rstd = rsqrtf(wave_sum(x0 * x0 + x1 * x1) * (1.f / 128) + EPS);
              const float y0 = x0 * rstd * kvnw.x, y1 = x1 * rstd * kvnw.y; *(LAS unsigned*)(sCKV + (wave * 8 + j) * 136 + 2 * lane) = pk2(y0, y1);
              if (ctx) *(f32x2*)(C.out + O_CKV + (((size_t)b * DEPTH + layer) * 256 + t) * 128 + 2 * lane) = (f32x2){y0, y1}; }
            { const float v = bf2f(rkr[j]); const float partner = dppf<0x128>(v); float o = v;
              if (!ctx) { const float rot = (lane & 8) ? partner : -partner; o = v * C.ropec()[t * 32 + (lane & 31)] + rot * C.ropes()[t * 32 + (lane & 31)]; }
              if (lane < 32) { C.krall()[krow * 32 + lane] = (bf16_t)(pk2(o, 0.f) & 0xffffu); if (ctx) C.out[O_KR + (((size_t)b * DEPTH + layer) * 256 + t) * 32 + lane] = v; } }
        }
        }
        __syncthreads();
        __builtin_amdgcn_sched_barrier(0);
        {
            int lane_ = lane; asm volatile("" : "+v"(lane_)); const int fr = lane_ & 15, fq = lane_ >> 4;
            const bf16_t* Bq = wl + WL_UQ + (unsigned)((48 * wave + fr) * 256 + fq * 8);
            f32x4 acc[4][3];
#pragma unroll
            for (int mt = 0; mt < 4; ++mt)
#pragma unroll
                for (int j = 0; j < 3; ++j) acc[mt][j] = (f32x4){0.f, 0.f, 0.f, 0.f};
#pragma unroll
            for (int kh = 0; kh < 2; ++kh) {
                bf16x8 xq[3][4];
#pragma unroll
                for (int j = 0; j < 3; ++j)
#pragma unroll
                    for (int k4 = 0; k4 < 4; ++k4) xq[j][k4] = *(const bf16x8*)(Bq + (j * 16 * 256 + (4 * kh + k4) * 32));
                __builtin_amdgcn_sched_barrier(0);
#pragma unroll
                for (int k4 = 0; k4 < 4; ++k4) { const int kk = 4 * kh + k4; bf16x8 ya[4];
#pragma unroll
                    for (int mt = 0; mt < 4; ++mt) ya[mt] = *(const LAS bf16x8*)(sQC + (16 * mt + fr) * 264 + kk * 32 + fq * 8);
#pragma unroll
                    for (int mt = 0; mt < 4; ++mt)
#pragma unroll
                        for (int j = 0; j < 3; ++j) acc[mt][j] = MFMA16P(xq[j][k4], ya[mt], acc[mt][j]); }
                __builtin_amdgcn_sched_barrier(0);
            }
#pragma unroll
            for (int mt = 0; mt < 4; ++mt) { bf16_t* qrow = C.qb() + (unsigned)((tile * 64 + 16 * mt + fr) * 512 + 48 * wave + 4 * fq);
#pragma unroll
                for (int j = 0; j < 3; ++j) { u32x2 o; o.x = pk2(acc[mt][j][0], acc[mt][j][1]); o.y = pk2(acc[mt][j][2], acc[mt][j][3]); *(u32x2*)(qrow + 16 * j) = o; } }
        }
        {
            __builtin_amdgcn_sched_barrier(0);
            int lane_ = lane; asm volatile("" : "+v"(lane_)); const int fr = lane_ & 15, fq = lane_ >> 4;
            const bf16_t* Bk = wl + WL_UKV + (unsigned)((64 * wave + fr) * 128 + fq * 8);
            bf16x8 xk[4][4];
#pragma unroll
            for (int j = 0; j < 4; ++j)
#pragma unroll
                for (int kk = 0; kk < 4; ++kk) xk[j][kk] = *(const bf16x8*)(Bk + (j * 16 * 128 + kk * 32));
            f32x4 acc[5][4];
#pragma unroll
            for (int mt = 0; mt < 5; ++mt)
#pragma unroll
                for (int j = 0; j < 4; ++j) acc[mt][j] = (f32x4){0.f, 0.f, 0.f, 0.f};
#pragma unroll
            for (int kk = 0; kk < 4; ++kk) { bf16x8 ya[5];
#pragma unroll
                for (int mt = 0; mt < 5; ++mt) ya[mt] = *(const LAS bf16x8*)(sCKV + (16 * mt + fr) * 136 + kk * 32 + fq * 8);
#pragma unroll
                for (int mt = 0; mt < 5; ++mt)
#pragma unroll
                    for (int j = 0; j < 4; ++j) acc[mt][j] = MFMA16P(xk[j][kk], ya[mt], acc[mt][j]); }
#pragma unroll
            for (int mt = 0; mt < 5; ++mt) { unsigned krow;
                if (mt < 4) { const int r = tile * 64 + 16 * mt + fr; krow = r < NCTXR ? (unsigned)r : 8192u + (unsigned)(((r - NCTXR) >> 10) * 1536 + 512 + ((r - NCTXR) & 1023)); }
                else { const int idx = 16 * tile + fr; krow = 8192u + (unsigned)((idx >> 9) * 1536 + (idx & 511)); }
                bf16_t* kvrow = C.kvb() + (krow * 512u + (unsigned)(64 * wave + 4 * fq));
#pragma unroll
                for (int j = 0; j < 4; ++j) { u32x2 o; o.x = pk2(acc[mt][j][0], acc[mt][j][1]); o.y = pk2(acc[mt][j][2], acc[mt][j][3]); *(u32x2*)(kvrow + 16 * j) = o; } }
        }
    }
}

#define LDS_BARRIER() do { asm volatile("s_waitcnt lgkmcnt(0)" ::: "memory"); __builtin_amdgcn_s_barrier(); asm volatile("" ::: "memory"); } while (0)
#define SCHED_FENCE() __builtin_amdgcn_sched_barrier(0)
#define MFMA16(x, y, c) __builtin_amdgcn_mfma_f32_16x16x32_bf16((x), (y), (c), 0, 0, 0)
constexpr int SC_Q = 0, SC_K = 18432, SC_KT = 36864, SC_VT = 54272, SC_P = 71680, SC_Q2 = 106496, SC_HT = 124928, SC_CUM = 134144, SC_LA = 134656, SC_DT = 135168;

__device__ __forceinline__ void scan_unit(Ctx& C, int layer, int kind  , bool ctx, int b, int h, int dir) {
    LAS unsigned char* lds = C.lds;
    TIDS; const int wid = wave, fr = lane & 15, fq = lane >> 4;
    const int L = ctx ? 256 : 1024, R0 = ctx ? b * 256 : NCTXR + b * 1024, nch = L >> 7;
    const bf16_t *qp, *kp, *vp; int pitch; float kscale, la_const = 0.f; bf16_t* yout; int ypitch; int NH;
    if (kind == 0) { const int g = h >> 2; qp = C.xbc() + 640 + g * 64; kp = C.xbc() + 512 + g * 64; vp = C.xbc() + h * 64; pitch = 768; kscale = 1.f;
        yout = C.yssd() + (size_t)dir * NTOK * 512 + h * 64; ypitch = 512; NH = 8; }
    else { qp = C.ub() + U_RQ + h * 64; kp = C.ub() + U_RK + h * 64; vp = C.ub() + U_RV + h * 64; pitch = UP; kscale = 0.125f;
        const float x = C.in(18)[layer * 8 + dir * 4 + h]; la_const = -log1pf(__expf(-x));
        yout = C.yret() + (size_t)dir * NTOK * 256 + h * 64; ypitch = 256; NH = 4; }
    const float* labp = C.lab() + dir * 8 + h; const float* dtbp = C.dtb() + dir * 8 + h;
    LAS bf16_t* sQ = (LAS bf16_t*)(lds + SC_Q); LAS bf16_t* sK = (LAS bf16_t*)(lds + SC_K); LAS bf16_t* sKT = (LAS bf16_t*)(lds + SC_KT); LAS bf16_t* sVT = (LAS bf16_t*)(lds + SC_VT);
    LAS bf16_t* sP = (LAS bf16_t*)(lds + SC_P); LAS bf16_t* sQ2 = (LAS bf16_t*)(lds + SC_Q2); LAS bf16_t* sHT = (LAS bf16_t*)(lds + SC_HT);
    LAS float* sCumAll = (LAS float*)(lds + SC_CUM);
    const int tn = wid >> 1, tp0 = (wid & 1) * 2;
    f32x4 Hacc[2];
    if (!ctx) { const float* st = (kind == 0 ? C.in(3) : C.in(4)) + ((((size_t)b * DEPTH + layer) * 2 + dir) * NH + h) * 4096;
#pragma unroll
        for (int q = 0; q < 2; ++q)
#pragma unroll
            for (int e = 0; e < 4; ++e) Hacc[q][e] = __builtin_nontemporal_load(st + (16 * tn + 4 * fq + e) * 64 + 16 * (tp0 + q) + fr); }
    else { Hacc[0] = (f32x4){0.f, 0.f, 0.f, 0.f}; Hacc[1] = Hacc[0]; }
    const int li = tid >> 3, p8 = tid & 7;
    u32x4 qv[2], kv[2], vv[2]; float dt_r[2];
#define SCAN_ISSUE(cc) do { _Pragma("unroll") for (int ps_ = 0; ps_ < 2; ++ps_) { const int pos_ = (cc) * 128 + li + 64 * ps_, t_ = dir ? L - 1 - pos_ : pos_; const size_t r_ = (size_t)(R0 + t_); \
        qv[ps_] = *(const u32x4*)(qp + r_ * pitch + p8 * 8); kv[ps_] = *(const u32x4*)(kp + r_ * pitch + p8 * 8); vv[ps_] = *(const u32x4*)(vp + r_ * pitch + p8 * 8); \
        dt_r[ps_] = kind == 0 ? dtbp[r_ * 16] : 1.0f; } } while (0)
    float cs_e = 0.f, cs_o = 0.f;
    if (wid < nch) { float a[2];
#pragma unroll
        for (int e = 0; e < 2; ++e) { const int pos = wid * 128 + 2 * lane + e, t = dir ? L - 1 - pos : pos; a[e] = (kind == 0 ? labp[(size_t)(R0 + t) * 16] : la_const) * 1.4426950408889634f; }
        float sc = a[0] + a[1];
#pragma unroll
        for (int o = 1; o < 64; o <<= 1) { const float v = __shfl_up(sc, o); if (lane >= o) sc += v; }
        cs_o = sc; cs_e = sc - a[1]; }
    SCAN_ISSUE(0);
    __syncthreads();
#pragma unroll
    for (int q = 0; q < 2; ++q) { u32x2 o; o.x = pk2(Hacc[q][0], Hacc[q][1]); o.y = pk2(Hacc[q][2], Hacc[q][3]); *(LAS u32x2*)(sHT + (16 * (tp0 + q) + fr) * 72 + 16 * tn + 4 * fq) = o; }
    if (wid < nch) *(LAS f32x2*)(sCumAll + wid * 128 + 2 * lane) = (f32x2){cs_e, cs_o};
    __syncthreads();
    for (int c = 0; c < nch; ++c) {
        const LAS float* sCum = sCumAll + c * 128;
        float cum_i[2]; const float cum_last = sCum[127];
#pragma unroll
        for (int ps = 0; ps < 2; ++ps) cum_i[ps] = sCum[li + 64 * ps];
#pragma unroll
        for (int ps = 0; ps < 2; ++ps) {
            const int i = li + 64 * ps, isw = i ^ (8 * p8);
            const float te = __builtin_amdgcn_exp2f(cum_last - cum_i[ps]) * kscale, dtv = dt_r[ps];
            *(LAS u32x4*)(sQ + i * 72 + p8 * 8) = qv[ps]; *(LAS u32x4*)(sK + i * 72 + p8 * 8) = kv[ps];
            const unsigned ka[4] = {kv[ps].x, kv[ps].y, kv[ps].z, kv[ps].w}, va[4] = {vv[ps].x, vv[ps].y, vv[ps].z, vv[ps].w};
#pragma unroll
            for (int e = 0; e < 4; ++e) {
                const unsigned kt = pk2(bflo(ka[e]) * te, bfhi(ka[e]) * te), vt = pk2(bflo(va[e]) * dtv, bfhi(va[e]) * dtv);
                sKT[(p8 * 8 + 2 * e) * 136 + isw] = (bf16_t)(kt & 0xffffu); sKT[(p8 * 8 + 2 * e + 1) * 136 + isw] = (bf16_t)(kt >> 16);
                sVT[(p8 * 8 + 2 * e) * 136 + isw] = (bf16_t)(vt & 0xffffu); sVT[(p8 * 8 + 2 * e + 1) * 136 + isw] = (bf16_t)(vt >> 16); }
        }
        if (c + 1 < nch) SCAN_ISSUE(c + 1);
        LDS_BARRIER();
        {
            const float kadj = kind == 0 ? 0.f : -3.f;
            int prt[5], pjt[5];
#pragma unroll
            for (int t = 0; t < 5; ++t) { const int p = wid + 8 * t; int rt = 0;
#pragma unroll
                for (int k = 1; k < 8; ++k) if (p >= k * (k + 1) / 2) rt = k;
                prt[t] = rt; pjt[t] = p - rt * (rt + 1) / 2; }
            {
                bf16x8 yq[4][2], xk[4][2]; f32x4 cj[4], s4[4]; float cumr[4];
#pragma unroll
                for (int t = 0; t < 4; ++t) { const int i = 16 * prt[t] + fr, jr = 16 * pjt[t] + fr;
                    yq[t][0] = *(const LAS bf16x8*)(sQ + i * 72 + fq * 8); yq[t][1] = *(const LAS bf16x8*)(sQ + i * 72 + 32 + fq * 8);
                    xk[t][0] = *(const LAS bf16x8*)(sK + jr * 72 + fq * 8); xk[t][1] = *(const LAS bf16x8*)(sK + jr * 72 + 32 + fq * 8);
                    cj[t] = *(const LAS f32x4*)(sCum + 16 * pjt[t] + 4 * fq); cumr[t] = sCum[i] + kadj; }
                SCHED_FENCE();
#pragma unroll
                for (int t = 0; t < 4; ++t) s4[t] = MFMA16(xk[t][0], yq[t][0], ((f32x4){0.f, 0.f, 0.f, 0.f}));
#pragma unroll
                for (int t = 0; t < 4; ++t) s4[t] = MFMA16(xk[t][1], yq[t][1], s4[t]);
                SCHED_FENCE();
#pragma unroll
                for (int t = 0; t < 4; ++t) { const int i = 16 * prt[t] + fr; float pv[4];
                    if (prt[t] == pjt[t]) {
#pragma unroll
                        for (int e = 0; e < 4; ++e) { const int j = 16 * pjt[t] + 4 * fq + e; pv[e] = s4[t][e] * __builtin_amdgcn_exp2f(j <= i ? cumr[t] - cj[t][e] : -1e30f); } }
                    else {
#pragma unroll
                        for (int e = 0; e < 4; ++e) pv[e] = s4[t][e] * __builtin_amdgcn_exp2f(cumr[t] - cj[t][e]); }
                    u32x2 o; o.x = pk2(pv[0], pv[1]); o.y = pk2(pv[2], pv[3]); *(LAS u32x2*)(sP + i * 136 + 16 * pjt[t] + 4 * fq) = o; }
            }
            if (wid < 4) {
                const int i = 16 * prt[4] + fr, jr = 16 * pjt[4] + fr;
                const bf16x8 y0 = *(const LAS bf16x8*)(sQ + i * 72 + fq * 8), y1 = *(const LAS bf16x8*)(sQ + i * 72 + 32 + fq * 8);
                const bf16x8 x0 = *(const LAS bf16x8*)(sK + jr * 72 + fq * 8), x1 = *(const LAS bf16x8*)(sK + jr * 72 + 32 + fq * 8);
                const f32x4 cj = *(const LAS f32x4*)(sCum + 16 * pjt[4] + 4 * fq); const float cumr = sCum[i] + kadj;
                f32x4 s4 = MFMA16(x0, y0, ((f32x4){0.f, 0.f, 0.f, 0.f})); s4 = MFMA16(x1, y1, s4);
                float pv[4];
#pragma unroll
                for (int e = 0; e < 4; ++e) { const int j = 16 * pjt[4] + 4 * fq + e; pv[e] = s4[e] * __builtin_amdgcn_exp2f(j <= i ? cumr - cj[e] : -1e30f); }
                u32x2 o; o.x = pk2(pv[0], pv[1]); o.y = pk2(pv[2], pv[3]); *(LAS u32x2*)(sP + i * 136 + 16 * pjt[4] + 4 * fq) = o;
            } else {
                const int rt = 2 * (wid - 4); *(LAS u32x2*)(sP + (16 * rt + fr) * 136 + 16 * (rt + 1) + 4 * fq) = (u32x2){0u, 0u};
            }
        }
        LDS_BARRIER();
        {
            const int i = 16 * wid + fr; f32x4 acc[4];
            {
                bf16x8 yq[2], xh[2][4], yp, xv[4]; f32x4 ah[4];
#pragma unroll
                for (int kk = 0; kk < 2; ++kk) { yq[kk] = *(const LAS bf16x8*)(sQ + i * 72 + kk * 32 + fq * 8);
#pragma unroll
                    for (int pt = 0; pt < 4; ++pt) xh[kk][pt] = *(const LAS bf16x8*)(sHT + (16 * pt + fr) * 72 + kk * 32 + fq * 8); }
                yp = *(const LAS bf16x8*)(sP + i * 136 + fq * 8);
#pragma unroll
                for (int pt = 0; pt < 4; ++pt) xv[pt] = *(const LAS bf16x8*)(sVT + (16 * pt + fr) * 136 + ((fq * 8) ^ (8 * ((2 * pt + (fr >> 3)) & 7))));
                const float ecr = __builtin_amdgcn_exp2f(sCum[i]);
                SCHED_FENCE();
#pragma unroll
                for (int pt = 0; pt < 4; ++pt) ah[pt] = MFMA16(xh[0][pt], yq[0], ((f32x4){0.f, 0.f, 0.f, 0.f}));
#pragma unroll
                for (int pt = 0; pt < 4; ++pt) acc[pt] = MFMA16(xv[pt], yp, ((f32x4){0.f, 0.f, 0.f, 0.f}));
#pragma unroll
                for (int pt = 0; pt < 4; ++pt) ah[pt] = MFMA16(xh[1][pt], yq[1], ah[pt]);
                SCHED_FENCE();
#pragma unroll
                for (int pt = 0; pt < 4; ++pt) acc[pt] = acc[pt] + ah[pt] * ecr;
            }
#define SCAN_PV_STEP(kk_) do { bf16x8 yp_ = *(const LAS bf16x8*)(sP + i * 136 + (kk_) * 32 + fq * 8); bf16x8 xv_[4]; \
                _Pragma("unroll") for (int pt = 0; pt < 4; ++pt) xv_[pt] = *(const LAS bf16x8*)(sVT + (16 * pt + fr) * 136 + (((kk_) * 32 + fq * 8) ^ (8 * ((2 * pt + (fr >> 3)) & 7)))); \
                SCHED_FENCE(); \
                _Pragma("unroll") for (int pt = 0; pt < 4; ++pt) acc[pt] = MFMA16(xv_[pt], yp_, acc[pt]); \
                SCHED_FENCE(); } while (0)
            if (wid >= 2) SCAN_PV_STEP(1);
            if (wid >= 4) SCAN_PV_STEP(2);
            if (wid >= 6) SCAN_PV_STEP(3);
#undef SCAN_PV_STEP
            const int pos = c * 128 + i, t = dir ? L - 1 - pos : pos; bf16_t* yr = yout + (size_t)(R0 + t) * ypitch;
#pragma unroll
            for (int pt = 0; pt < 4; ++pt) { u32x2 o; o.x = pk2(acc[pt][0], acc[pt][1]); o.y = pk2(acc[pt][2], acc[pt][3]); *(u32x2*)(yr + 16 * pt + 4 * fq) = o; }
        }
        {
            const float dec = __builtin_amdgcn_exp2f(cum_last);
            bf16x8 xk[4], yv[2][4];
#pragma unroll
            for (int kk = 0; kk < 4; ++kk) { xk[kk] = *(const LAS bf16x8*)(sKT + (16 * tn + fr) * 136 + ((kk * 32 + fq * 8) ^ (8 * ((2 * tn + (fr >> 3)) & 7))));
#pragma unroll
                for (int q = 0; q < 2; ++q) yv[q][kk] = *(const LAS bf16x8*)(sVT + (16 * (tp0 + q) + fr) * 136 + ((kk * 32 + fq * 8) ^ (8 * ((2 * (tp0 + q) + (fr >> 3)) & 7)))); }
            Hacc[0] = Hacc[0] * dec; Hacc[1] = Hacc[1] * dec;
            SCHED_FENCE();
#pragma unroll
            for (int kk = 0; kk < 4; ++kk)
#pragma unroll
                for (int q = 0; q < 2; ++q) Hacc[q] = MFMA16(xk[kk], yv[q][kk], Hacc[q]);
            SCHED_FENCE();
        }
        LDS_BARRIER();
#pragma unroll
        for (int q = 0; q < 2; ++q) { u32x2 o; o.x = pk2(Hacc[q][0], Hacc[q][1]); o.y = pk2(Hacc[q][2], Hacc[q][3]); *(LAS u32x2*)(sHT + (16 * (tp0 + q) + fr) * 72 + 16 * tn + 4 * fq) = o; }
    }
#undef SCAN_ISSUE
    if (ctx) { float* so = C.out + (kind == 0 ? O_SSD : O_RET) + ((((size_t)b * DEPTH + layer) * 2 + dir) * NH + h) * 4096;
#pragma unroll
        for (int q = 0; q < 2; ++q)
#pragma unroll
            for (int e = 0; e < 4; ++e) so[(16 * tn + 4 * fq + e) * 64 + 16 * (tp0 + q) + fr] = Hacc[q][e]; }
}

constexpr int AT_K = 0, AT_VT = 26624, AT_BUF = 44032;
template <int MODE = 0>
__device__ __forceinline__ void attn_unit(Ctx& C, bool ctx, int b, int h, int qb) {
    LAS unsigned char* lds = C.lds;
    TIDS; const int wid = wave, fr = lane & 15, fq = lane >> 4;
    const int R0 = ctx ? b * 256 : NCTXR + b * 1024, KR0 = ctx ? b * 256 : 8192 + b * 1536, S = ctx ? 256 : 1536, nkt = S >> 7;
    const int tq = qb * 128 + 16 * wid + fr; const size_t rq = (size_t)(R0 + tq);
    const float SCL = 0.10206207261596577f * 1.4426950408889634f;
    const int lj = tid >> 3, p8 = tid & 7, rj = tid >> 2, rp = tid & 3;
    const bf16_t* kvbase = C.kvb() + (size_t)(KR0 + lj) * 512 + h * 128 + p8 * 8; const bf16_t* krbase = C.krall() + (size_t)(KR0 + rj) * 32 + rp * 8;
    u32x4 kn[2], vn[2], kr8;
#define ATT_ISSUE(kt_) do { const bf16_t* kvrow_ = kvbase + (size_t)(kt_) * 128 * 512; kn[0] = *(const u32x4*)(kvrow_); kn[1] = *(const u32x4*)(kvrow_ + 64 * 512); \
        vn[0] = *(const u32x4*)(kvrow_ + 64); vn[1] = *(const u32x4*)(kvrow_ + 64 * 512 + 64); kr8 = *(const u32x4*)(krbase + (size_t)(kt_) * 128 * 32); } while (0)
    ATT_ISSUE(0);
    bf16x8 qf[3];
    { const bf16_t* qrow = C.qb() + rq * 512 + h * 96;
#pragma unroll
      for (int kk = 0; kk < 3; ++kk) { const u32x4 raw = *(const u32x4*)(qrow + kk * 32 + fq * 8); float x[8] = {bflo(raw.x), bfhi(raw.x), bflo(raw.y), bfhi(raw.y), bflo(raw.z), bfhi(raw.z), bflo(raw.w), bfhi(raw.w)};
          if (kk == 2 && !ctx) {
#pragma unroll
              for (int e = 0; e < 8; ++e) { const float partner = __shfl_xor(x[e], 16); const float rot = (fq & 1) ? partner : -partner; const int d = fq * 8 + e;
                  x[e] = x[e] * C.ropec()[tq * 32 + d] + rot * C.ropes()[tq * 32 + d]; } }
          u32x4 o; o.x = pk2(x[0] * SCL, x[1] * SCL); o.y = pk2(x[2] * SCL, x[3] * SCL); o.z = pk2(x[4] * SCL, x[5] * SCL); o.w = pk2(x[6] * SCL, x[7] * SCL);
          qf[kk] = __builtin_bit_cast(bf16x8, o); } }
    float m_run = -1e30f, l_run = 0.f; f32x4 o[4];
#pragma unroll
    for (int pt = 0; pt < 4; ++pt) o[pt] = (f32x4){0.f, 0.f, 0.f, 0.f};
    __syncthreads();
    for (int kt = 0; kt < nkt; ++kt) {
        LAS bf16_t* sK = (LAS bf16_t*)(lds + (kt & 1) * AT_BUF + AT_K); LAS bf16_t* sVT = (LAS bf16_t*)(lds + (kt & 1) * AT_BUF + AT_VT);
        if (MODE != 2) { *(LAS u32x4*)(sK + rj * 104 + 64 + rp * 8) = kr8;
#pragma unroll
          for (int ps = 0; ps < 2; ++ps) { const int j = lj + 64 * ps, jsw = j ^ (8 * p8); *(LAS u32x4*)(sK + j * 104 + p8 * 8) = kn[ps];
              const unsigned va[4] = {vn[ps].x, vn[ps].y, vn[ps].z, vn[ps].w};
#pragma unroll
              for (int e = 0; e < 4; ++e) { sVT[(p8 * 8 + 2 * e) * 136 + jsw] = (bf16_t)(va[e] & 0xffffu); sVT[(p8 * 8 + 2 * e + 1) * 136 + jsw] = (bf16_t)(va[e] >> 16); } } }
        if (MODE != 2 && kt + 1 < nkt) ATT_ISSUE(kt + 1);
        LDS_BARRIER();
        if (MODE == 1) continue;
        f32x4 s[8]; float mx = -1e30f;
        {
            bf16x8 kf[8][3];
#pragma unroll
            for (int jt = 0; jt < 8; ++jt)
#pragma unroll
                for (int kk = 0; kk < 3; ++kk) kf[jt][kk] = *(const LAS bf16x8*)(sK + (16 * jt + fr) * 104 + kk * 32 + fq * 8);
            SCHED_FENCE();
#pragma unroll
            for (int jt = 0; jt < 8; ++jt) s[jt] = MFMA16(kf[jt][0], qf[0], ((f32x4){0.f, 0.f, 0.f, 0.f}));
#pragma unroll
            for (int kk = 1; kk < 3; ++kk)
#pragma unroll
                for (int jt = 0; jt < 8; ++jt) s[jt] = MFMA16(kf[jt][kk], qf[kk], s[jt]);
            SCHED_FENCE();
        }
        u32x2 va[4][4], vb[4][4];
#pragma unroll
        for (int kk = 0; kk < 4; ++kk)
#pragma unroll
            for (int pt = 0; pt < 4; ++pt) { const LAS bf16_t* vr = sVT + (16 * pt + fr) * 136; const int sw = 8 * ((2 * pt + (fr >> 3)) & 7); va[kk][pt] = *(const LAS u32x2*)(vr + ((32 * kk + 4 * fq) ^ sw)); vb[kk][pt] = *(const LAS u32x2*)(vr + ((32 * kk + 16 + 4 * fq) ^ sw)); }
        SCHED_FENCE();
#pragma unroll
        for (int jt = 0; jt < 8; ++jt) mx = fmaxf(mx, fmaxf(fmaxf(s[jt][0], s[jt][1]), fmaxf(s[jt][2], s[jt][3])));
        mx = fmaxf(mx, __shfl_xor(mx, 16)); mx = fmaxf(mx, __shfl_xor(mx, 32));
        const float m_new = fmaxf(m_run, mx), alpha = __builtin_amdgcn_exp2f(m_run - m_new); m_run = m_new;
        float ls = 0.f;
#pragma unroll
        for (int jt = 0; jt < 8; ++jt)
#pragma unroll
            for (int e = 0; e < 4; ++e) { s[jt][e] = __builtin_amdgcn_exp2f(s[jt][e] - m_new); ls += s[jt][e]; }
        l_run = l_run * alpha + ls;
#pragma unroll
        for (int pt = 0; pt < 4; ++pt) o[pt] = o[pt] * alpha;
        bf16x8 yp[4];
#pragma unroll
        for (int kk = 0; kk < 4; ++kk) { u32x4 yw; yw.x = pk2(s[2 * kk][0], s[2 * kk][1]); yw.y = pk2(s[2 * kk][2], s[2 * kk][3]); yw.z = pk2(s[2 * kk + 1][0], s[2 * kk + 1][1]); yw.w = pk2(s[2 * kk + 1][2], s[2 * kk + 1][3]);
            yp[kk] = __builtin_bit_cast(bf16x8, yw); }
        SCHED_FENCE();
#pragma unroll
        for (int kk = 0; kk < 4; ++kk)
#pragma unroll
            for (int pt = 0; pt < 4; ++pt) { const u32x4 xw = (u32x4){va[kk][pt].x, va[kk][pt].y, vb[kk][pt].x, vb[kk][pt].y}; o[pt] = MFMA16(__builtin_bit_cast(bf16x8, xw), yp[kk], o[pt]); }
        SCHED_FENCE();
    }
#undef ATT_ISSUE
    float l = l_run + __shfl_xor(l_run, 16); l += __shfl_xor(l, 32); const float inv = 1.0f / l;
    if (MODE != 0 && l != 12345.678f) return;
    bf16_t* orow = C.abuf() + rq * 1024 + 768 + h * 64;
#pragma unroll
    for (int pt = 0; pt < 4; ++pt) { u32x2 w; w.x = pk2(o[pt][0] * inv, o[pt][1] * inv); w.y = pk2(o[pt][2] * inv, o[pt][3] * inv); *(u32x2*)(orow + 16 * pt + 4 * fq) = w; }
}

__device__ __forceinline__ int mix_unit_of(int bid, int G, int k) {
    if (G != 256) { const int idx = bid + k * G; return idx < 1472 ? idx : -1; }
    if (k == 0) return bid;
    if (bid < 192) {
        if (k == 1) return 256 + bid;
        if (k == 2 || k == 3) return 448 + 384 + 2 * bid + (k - 2);
        if (k == 4) return 448 + 768 + 64 + bid;
        return -1; }
    const int j = bid - 192;
    if (k <= 6) return 448 + 6 * j + (k - 1);
    if (k == 7) return 448 + 768 + j;
    return -1;
}
__device__ __forceinline__ void phase_mixers(Ctx& C, int layer) {
    for (int k = 0;; ++k) {
        int idx = mix_unit_of(C.bid, C.G, k); if (idx < 0) break;
        if (idx < 256) { const int rest = idx >> 3; attn_unit<0>(C, false, idx & 7, rest >> 3, rest & 7); continue; }
        idx -= 256;
        if (idx < 192) { const int b = idx & 7, rem = idx >> 3;
            if (rem < 16) scan_unit(C, layer, 0, false, b, rem >> 1, rem & 1); else scan_unit(C, layer, 1, false, b, (rem - 16) >> 1, rem & 1);
            continue; }
        idx -= 192;
        if (idx < 512) { scan_unit(C, layer, 0, true, idx >> 4, (idx >> 1) & 7, idx & 1); continue; }
        idx -= 512;
        if (idx < 256) { scan_unit(C, layer, 1, true, idx >> 3, (idx >> 1) & 3, idx & 1); continue; }
        idx -= 256;
        attn_unit<0>(C, true, idx >> 3, (idx >> 1) & 3, idx & 1);
    }
}

__device__ __forceinline__ void phase_mix(Ctx& C, int layer) {
    TIDS;
    const int gw = C.bid * NWAVES + wave, NGW = C.G * NWAVES;
    const float Dh = C.in(16)[layer * 8 + (lane >> 3)];
    const f32x4 nw0 = *(const f32x4*)(C.in(17) + layer * 512 + 8 * lane), nw1 = *(const f32x4*)(C.in(17) + layer * 512 + 8 * lane + 4);
    const f32x4 gw4 = *(const f32x4*)(C.in(19) + layer * 256 + 4 * lane);
    for (int r0 = gw; r0 < NTOK; r0 += 2 * NGW) {
        u32x4 yf[2], yb[2], xs[2], z[2]; u32x2 of[2], ob[2], g[2]; int rr[2];
#pragma unroll
        for (int q = 0; q < 2; ++q) { const int r = xcd_row(r0 + q * NGW < NTOK ? r0 + q * NGW : r0, C.G); rr[q] = r; const bf16_t* ur = C.ub() + (size_t)r * UP;
            yf[q] = *(const u32x4*)(C.yssd() + (size_t)r * 512 + 8 * lane); yb[q] = *(const u32x4*)(C.yssd() + (size_t)(NTOK + r) * 512 + 8 * lane);
            xs[q] = *(const u32x4*)(C.xbc() + (size_t)r * 768 + 8 * lane); z[q] = *(const u32x4*)(ur + 8 * lane);
            of[q] = *(const u32x2*)(C.yret() + (size_t)r * 256 + 4 * lane); ob[q] = *(const u32x2*)(C.yret() + (size_t)(NTOK + r) * 256 + 4 * lane); g[q] = *(const u32x2*)(ur + U_RG + 4 * lane); }
#pragma unroll
        for (int q = 0; q < 2; ++q) { const int r = rr[q];
          { const unsigned yfa[4] = {yf[q].x, yf[q].y, yf[q].z, yf[q].w}, yba[4] = {yb[q].x, yb[q].y, yb[q].z, yb[q].w}, xsa[4] = {xs[q].x, xs[q].y, xs[q].z, xs[q].w}, za[4] = {z[q].x, z[q].y, z[q].z, z[q].w};
            float v[8]; float ss = 0.f;
#pragma unroll
            for (int e = 0; e < 4; ++e) { v[2 * e] = (bflo(yfa[e]) + bflo(yba[e]) + Dh * bflo(xsa[e])) * pg8::silu_f(bflo(za[e])); v[2 * e + 1] = (bfhi(yfa[e]) + bfhi(yba[e]) + Dh * bfhi(xsa[e])) * pg8::silu_f(bfhi(za[e]));
                ss += v[2 * e] * v[2 * e] + v[2 * e + 1] * v[2 * e + 1]; }
            const float rstd = rsqrtf(wave_sum(ss) * (1.f / 512) + EPS);
            u32x4 o; o.x = pk2(v[0] * rstd * nw0.x, v[1] * rstd * nw0.y); o.y = pk2(v[2] * rstd * nw0.z, v[3] * rstd * nw0.w); o.z = pk2(v[4] * rstd * nw1.x, v[5] * rstd * nw1.y); o.w = pk2(v[6] * rstd * nw1.z, v[7] * rstd * nw1.w);
            *(u32x4*)(C.abuf() + (size_t)r * 1024 + 8 * lane) = o; }
          { const float o0 = bflo(of[q].x) + bflo(ob[q].x), o1 = bfhi(of[q].x) + bfhi(ob[q].x), o2 = bflo(of[q].y) + bflo(ob[q].y), o3 = bfhi(of[q].y) + bfhi(ob[q].y);
            const float s4 = row16_sum((o0 + o1) + (o2 + o3));
            const float mu = s4 * (1.f / 64); const float d0 = o0 - mu, d1 = o1 - mu, d2 = o2 - mu, d3 = o3 - mu; const float vq = row16_sum((d0 * d0 + d1 * d1) + (d2 * d2 + d3 * d3));
            const float rs = rsqrtf(vq * (1.f / 64) + EPS);
            u32x2 o; o.x = pk2(d0 * rs * gw4.x * pg8::silu_f(bflo(g[q].x)), d1 * rs * gw4.y * pg8::silu_f(bfhi(g[q].x))); o.y = pk2(d2 * rs * gw4.z * pg8::silu_f(bflo(g[q].y)), d3 * rs * gw4.w * pg8::silu_f(bfhi(g[q].y)));
            *(u32x2*)(C.abuf() + (size_t)r * 1024 + 512 + 4 * lane) = o; }
        }
    }
}

#define XB_TMO      128
#define XB_XCNT(j)  (256  + 64 * (j))
#define XB_XSUB(j)  (1280 + 64 * (j))
#define XB_XGEN(j)  (2304 + 64 * (j))
#define XB_TOP      3328
#define XB_TOPGEN   3392
#define XCD_BAR_WORDS 3456
#define XB_SPIN_CAP (1u << 18)
__device__ __forceinline__ unsigned xb_ld(unsigned* p)              { return __hip_atomic_load(p, __ATOMIC_RELAXED, __HIP_MEMORY_SCOPE_AGENT); }
__device__ __forceinline__ unsigned xb_add(unsigned* p, unsigned v) { return __hip_atomic_fetch_add(p, v, __ATOMIC_RELAXED, __HIP_MEMORY_SCOPE_AGENT); }
__device__ __forceinline__ unsigned xb_xcc_id() { return (unsigned)__builtin_amdgcn_s_getreg((3 << 11) | 20) & 0xFu; }
#define XB_SPIN(cond, bar) do { unsigned _sp = 0; while (cond) { __builtin_amdgcn_s_sleep(1); \
    if ((++_sp & 255u) == 0u) { if (xb_ld(&(bar)[XB_TMO])) break; if (_sp > XB_SPIN_CAP) { atomicAdd(&(bar)[XB_TMO], 1u); break; } } } } while (0)
struct XcdBarrier { unsigned* bar; unsigned x; volatile LAS unsigned* st; };
__device__ __forceinline__ XcdBarrier xcd_barrier_post(unsigned* bar, volatile LAS unsigned* st) {
    XcdBarrier b; b.bar = bar; b.x = xb_xcc_id(); b.st = st;
    if (threadIdx.x == 0) (void)xb_add(&bar[XB_XCNT(b.x)], 1u);
    return b;
}
__device__ __forceinline__ void xcd_barrier_complete(unsigned* bar, unsigned x, unsigned& nloc, unsigned& nx) {
    const unsigned G = gridDim.x * gridDim.y * gridDim.z;
    unsigned sum, cnt, mine, sp = 0u;
    for (;;) {
        sum = 0u; cnt = 0u; mine = 0u;
#pragma unroll
        for (unsigned j = 0; j < 16; ++j) { const unsigned c = xb_ld(&bar[XB_XCNT(j)]); sum += c; cnt += (c > 0u) ? 1u : 0u; mine = (j == x) ? c : mine; }
        if (sum == G) break;
        __builtin_amdgcn_s_sleep(1);
        if ((++sp & 255u) == 0u) { if (xb_ld(&bar[XB_TMO])) break; if (sp > XB_SPIN_CAP) { atomicAdd(&bar[XB_TMO], 1u); break; } }
    }
    nloc = mine > 0u ? mine : 1u; nx = cnt > 0u ? cnt : 1u;
}
__device__ __forceinline__ void xcd_barrier(const XcdBarrier& b) {
    asm volatile("s_waitcnt vmcnt(0)" ::: "memory");
    __syncthreads();
    if (threadIdx.x == 0) {
        unsigned* bar = b.bar;
        __builtin_amdgcn_s_waitcnt(0);
        unsigned nloc = b.st[0], nx = b.st[1];
        if (nloc == 0u) { xcd_barrier_complete(bar, b.x, nloc, nx); b.st[0] = nloc; b.st[1] = nx; }
        const unsigned old = xb_add(&bar[XB_XSUB(b.x)], 1u);
        const unsigned gen = old / nloc;
        if (old + 1u == (gen + 1u) * nloc) {
            __builtin_amdgcn_fence(__ATOMIC_RELEASE, "agent");
            asm volatile("s_waitcnt vmcnt(0)" ::: "memory");
            const unsigned og = xb_add(&bar[XB_TOP], 1u);
            const unsigned tg = og / nx;
            if (og + 1u == (tg + 1u) * nx) xb_add(&bar[XB_TOPGEN], 1u);
            else XB_SPIN(xb_ld(&bar[XB_TOPGEN]) == tg, bar);
            __builtin_amdgcn_fence(__ATOMIC_ACQUIRE, "agent");
            xb_add(&bar[XB_XGEN(b.x)], 1u);
            asm volatile("s_waitcnt vmcnt(0)" ::: "memory");
        } else {
            XB_SPIN(xb_ld(&bar[XB_XGEN(b.x)]) == gen, bar);
            __builtin_amdgcn_fence(__ATOMIC_ACQUIRE, "agent");
            asm volatile("s_waitcnt vmcnt(0)" ::: "memory");
        }
    }
    __syncthreads();
}
constexpr int MISC_OFF = 141312;
constexpr size_t WS_BAR = 65536;

constexpr int NSUB = 9, NPHASE = 2 + NSUB * DEPTH;

__global__ void __launch_bounds__(NTHR) mk_fwd(Args args) {
    extern __shared__ __attribute__((aligned(16))) unsigned char lds_raw[];
    {
        LAS unsigned long long* ptab = (LAS unsigned long long*)((LAS unsigned char*)lds_raw + PT_OFF);
        if (threadIdx.x < 29) ptab[threadIdx.x] = (unsigned long long)args.in[threadIdx.x];
        if (threadIdx.x < 32) ((LAS unsigned*)((LAS unsigned char*)lds_raw + MISC_OFF))[threadIdx.x] = 0u;
        __syncthreads();
    }
    XcdBarrier xbar; xbar.bar = (unsigned*)(args.ws + WS_BAR); xbar.x = 0; xbar.st = nullptr;
    if (MK_SINGLE) xbar = xcd_barrier_post((unsigned*)(args.ws + WS_BAR), (volatile LAS unsigned*)((LAS unsigned char*)lds_raw + MISC_OFF) + 8);
    cg::grid_group grid = cg::this_grid();
    int probe_rep = 0;
    for (int ph = args.ph_lo; ph < args.ph_hi; ++ph) {
        Ctx C; C.lds = (LAS unsigned char*)lds_raw; C.G = gridDim.x; C.bid = blockIdx.x;
        { GAS unsigned char* ws_ = (GAS unsigned char*)args.ws; GAS float* out_ = (GAS float*)args.out; asm volatile("" : "+s"(ws_), "+s"(out_)); C.ws = (unsigned char*)ws_; C.out = (float*)out_; }
        if (ph == 0) phase_prologue(C);
        else if (ph == NPHASE - 1) phase_norm_b<1>(C, C.in(28), nullptr, 0, 0);
        else {
            const int layer = (ph - 1) / NSUB, sub = (ph - 1) % NSUB;
            const float* modl = C.mod() + (size_t)layer * 9 * 6144; bf16_t* wl = C.wts() + (size_t)layer * WL_TOTAL;
            switch (sub) {
            case 0: if (layer == 0) phase_norm<0>(C, C.in(0), C.in(1), C.in(10), modl, 0, 1024); else phase_norm_b<0>(C, C.in(10) + layer * DM, modl, 0, 1024); break;
            case 1: { pg8::Gemm g{C.abuf(), wl + WL_IN, NTOK, UP, DM}; pg8::StaticOrder S; S.init(NTOK, UP, C.G, C.bid); pg8::EpiBf16 E{C.ub(), UP};
                      pg8::gemm_phase<pg8::EpiBf16, pg8::StaticOrder, true, true>(C.lds, g, S, E);
                      if (layer == 0) {
                          const int rem = S.nwg % C.G; const bool all = rem == 0;
                          if (all || C.bid >= rem) { TIDS; (void)tid; __syncthreads(); convert_weights(C, 0, ((all ? C.bid : C.bid - rem)) * NWAVES + wave, (all ? C.G : C.G - rem) * NWAVES, wave, lane, 2); }
                      } } break;
            case 2: phase_prep(C, layer); break;
            case 3: phase_mixers(C, layer); break;
            case 4: phase_mix(C, layer); break;
            case 5: { pg8::Gemm g{C.abuf(), wl + WL_OUT, NTOK, DM, DM}; pg8::StaticOrder S; S.init(NTOK, DM, C.G, C.bid); pg8::EpiRes E{layer == 0 ? C.in(0) : nullptr, layer == 0 ? C.in(1) : nullptr, C.xb(), modl + 2048};
                      pg8::gemm_phase<pg8::EpiRes, pg8::StaticOrder, false, true>(C.lds, g, S, E); } break;
            case 6: phase_norm_b<0>(C, C.in(25) + layer * DM, modl, 3072, 4096); break;
            case 7: { pg8::Gemm g{C.abuf(), wl + WL_W1, NTOK, 2 * DFF, DM}; pg8::StaticOrder S; S.init(NTOK, 2 * DFF, C.G, C.bid); pg8::EpiSwiGLU E{C.ub(), DFF};
                      pg8::gemm_phase<pg8::EpiSwiGLU, pg8::StaticOrder, true, true>(C.lds, g, S, E);
                      if (layer + 1 < DEPTH) {
                          const int rem = S.nwg % C.G; const bool all = rem == 0;
                          if (all || C.bid >= rem) { TIDS; (void)tid; __syncthreads(); convert_weights(C, layer + 1, ((all ? C.bid : C.bid - rem)) * NWAVES + wave, (all ? C.G : C.G - rem) * NWAVES, wave, lane); }
                      } } break;
            case 8: { pg8::Gemm g{C.ub(), wl + WL_W2, NTOK, DM, DFF}; pg8::StaticOrder S; S.init(NTOK, DM, C.G, C.bid); pg8::EpiRes E{nullptr, nullptr, C.xb(), modl + 5120};
                      pg8::gemm_phase<pg8::EpiRes, pg8::StaticOrder, false, true>(C.lds, g, S, E); } break;
            }
        }
        if (ph + 1 < args.ph_hi) { if (args.ph_hi > 1000) grid.sync(); else xcd_barrier(xbar); }
        if (PROBE_SUB >= 0) { if (((ph > 0 && ph < NPHASE - 1 && (ph - 1) % NSUB == PROBE_SUB) || (PROBE_SUB == 100 && ph == 0)) && probe_rep == 0) { probe_rep = 1; --ph; } else probe_rep = 0; }
    }
}

extern "C" void kernel_launch(void* const* d_in, const int* in_sizes, int n_in, void* d_out, int out_size, void* d_ws, size_t ws_size, hipStream_t stream) {
    static int grid = 0;
    if (grid == 0) {
        if (n_in != 29 || ws_size < WS_END) { fprintf(stderr, "kernel_launch: unexpected inputs (n_in %d) or workspace %zu < %zu\n", n_in, ws_size, (size_t)WS_END); grid = -1; return; }
        int dev = 0, cus = 0, per_cu = 0;
        hipGetDevice(&dev); hipDeviceGetAttribute(&cus, hipDeviceAttributeMultiprocessorCount, dev);
        hipFuncSetAttribute((const void*)mk_fwd, hipFuncAttributeMaxDynamicSharedMemorySize, LDS_BYTES);
        hipOccupancyMaxActiveBlocksPerMultiprocessor(&per_cu, (const void*)mk_fwd, NTHR, LDS_BYTES);
        if (per_cu < 1) { fprintf(stderr, "kernel_launch: occupancy query says %d blocks per CU\n", per_cu); per_cu = 1; }
        (void)hipGetLastError();
        grid = cus * 1;
    }
    if (grid < 0) return;
    Args a{};
    for (int i = 0; i < 29; ++i) a.in[i] = (const float*)d_in[i];
    a.out = (float*)d_out; a.ws = (unsigned char*)d_ws;
#if MK_SINGLE
    if (hipMemsetAsync(d_ws, 0, 1u << 20, stream) != hipSuccess) { fprintf(stderr, "kernel_launch: memset failed\n"); return; }
    a.ph_lo = 0; a.ph_hi = NPHASE;
    void* kargs[] = {&a};
    hipError_t e = hipLaunchCooperativeKernel((const void*)mk_fwd, dim3(grid), dim3(NTHR), kargs, LDS_BYTES, stream);
    if (e != hipSuccess) fprintf(stderr, "cooperative launch failed: %s (grid %d)\n", hipGetErrorString(e), grid);
#else
    for (int ph = 0; ph < NPHASE; ++ph) { a.ph_lo = ph; a.ph_hi = ph + 1; hipLaunchKernelGGL(mk_fwd, dim3(grid), dim3(NTHR), LDS_BYTES, stream, a); }
#endif
}
```

```cpp
#include <hip/hip_runtime.h>
#include <hip/hip_cooperative_groups.h>
#include <cstdio>
#include <cstdint>
namespace cg = cooperative_groups;

#ifndef MK_SINGLE
#define MK_SINGLE 1
#endif

#ifndef PROBE_MIX
#define PROBE_MIX 0
#endif
#ifndef PROBE_NOX
#define PROBE_NOX 0
#endif
#ifndef PROBE_SUB
#define PROBE_SUB -1
#endif
#define LAS __attribute__((address_space(3)))
#define GAS __attribute__((address_space(1)))
typedef unsigned short bf16_t;
typedef short bf16x8 __attribute__((ext_vector_type(8)));
typedef float f32x4 __attribute__((ext_vector_type(4)));
typedef float f32x2 __attribute__((ext_vector_type(2)));
typedef unsigned u32x4 __attribute__((ext_vector_type(4)));
typedef unsigned u32x2 __attribute__((ext_vector_type(2)));

namespace pg8 {
constexpr int BM = 256, BK = 64, HALF = 128, HTB = HALF * BK * 2, STAGE_BYTES = 8 * HTB, NXCD = 8, WGM = 8;
__host__ __device__ __forceinline__ int lds_byte(int r, int c) { const int st = (r >> 4) * 2 + (c >> 5), rr = r & 15, cc = c & 31, ob = rr * 64 + cc * 2; return st * 1024 + (ob ^ (((ob >> 9) & 1) << 5)); }
__host__ __device__ __forceinline__ void stage_rc(int b, int& R, int& C) { const int st = b / 1024, sb = b % 1024, swz = sb ^ (((sb >> 9) & 1) << 5); R = (st >> 1) * 16 + swz / 64; C = (st & 1) * 32 + (swz % 64) / 2; }
__host__ __device__ __forceinline__ int perm32(int rho) { const int n = rho >> 4, i = rho & 15; return 8 * (i >> 2) + 4 * n + (i & 3); }

struct Unit { int pm, pn; };
struct Gemm { const bf16_t* A; const bf16_t* Bt; int M, N, K; };

struct StaticOrder {
    int nM, nN, nwg, G, c;
    __host__ __device__ void init(int M, int N, int G_, int c_) { nM = M / BM; nN = N / BM; nwg = nM * nN; G = G_; c = c_; }
    __host__ __device__ bool next(int i, Unit& u) const {
        const long L = (long)i * G + c; if (L >= nwg) return false;
        int wgid = (int)L; { const int q = nwg / NXCD, r = nwg % NXCD, xcd = wgid % NXCD, off = wgid / NXCD; wgid = (xcd < r ? xcd * (q + 1) : r * (q + 1) + (xcd - r) * q) + off; }
        const int nig = WGM * nN, gid = wgid / nig, fm = gid * WGM, gsz = (nM - fm) < WGM ? (nM - fm) : WGM;
        u.pm = fm + ((wgid % nig) % gsz); u.pn = (wgid % nig) / gsz; return true;
    }
    __device__ __forceinline__ void a_ready(const Unit&) const {}
    __device__ __forceinline__ void done(const Unit&) const {}
};

__device__ __forceinline__ void st16_wt(void* p, u32x4 v) { asm volatile("global_store_dwordx4 %0, %1, off sc1" :: "v"(p), "v"(v) : "memory"); }
__device__ __forceinline__ unsigned cvt_pk_bf16(float lo, float hi) { unsigned r; asm volatile("v_cvt_pk_bf16_f32 %0, %1, %2" : "=v"(r) : "v"(lo), "v"(hi)); return r; }

struct EpiBf16 {
    static constexpr bool PERM = true, AFTER_DRAIN = false;
    bf16_t* O; int ldc;
    __device__ __forceinline__ void operator()(const f32x4 (&acc)[2][2][4][2], const Unit& u, int wr, int wc, int fr_, int fq_) const {
        int fr = fr_, fq = fq_; asm volatile("" : "+v"(fr), "+v"(fq));
        const int row0 = u.pm * BM + wr * 64 + fr; const int col0 = u.pn * BM + wc * 32 + 8 * fq;
#pragma unroll
        for (int ai = 0; ai < 2; ++ai)
#pragma unroll
            for (int m = 0; m < 4; ++m) { bf16_t* rowp = O + (size_t)(row0 + ai * HALF + m * 16) * ldc + col0;
#pragma unroll
                for (int bj = 0; bj < 2; ++bj) { const f32x4 v0 = acc[ai][bj][m][0], v1 = acc[ai][bj][m][1];
                    u32x4 w; w.x = cvt_pk_bf16(v0[0], v0[1]); w.y = cvt_pk_bf16(v0[2], v0[3]); w.z = cvt_pk_bf16(v1[0], v1[1]); w.w = cvt_pk_bf16(v1[2], v1[3]);
                    st16_wt(rowp + bj * HALF, w); } }
    }
};
__device__ __forceinline__ float silu_f(float a) { return a * __builtin_amdgcn_rcpf(1.0f + __builtin_amdgcn_exp2f(-1.4426950408889634f * a)); }
struct EpiSwiGLU {
    static constexpr bool PERM = true, AFTER_DRAIN = false;
    bf16_t* O; int ldc;
    __device__ __forceinline__ void operator()(const f32x4 (&acc)[2][2][4][2], const Unit& u, int wr, int wc, int fr_, int fq_) const {
        int fr = fr_, fq = fq_; asm volatile("" : "+v"(fr), "+v"(fq));
        const int row0 = u.pm * BM + wr * 64 + fr; const int col0 = u.pn * HALF + wc * 32 + 8 * fq;
#pragma unroll
        for (int ai = 0; ai < 2; ++ai)
#pragma unroll
            for (int m = 0; m < 4; ++m) { bf16_t* rowp = O + (size_t)(row0 + ai * HALF + m * 16) * ldc + col0;
                const f32x4 a0 = acc[ai][0][m][0], a1 = acc[ai][0][m][1], g0 = acc[ai][1][m][0], g1 = acc[ai][1][m][1];
                u32x4 w;
                w.x = cvt_pk_bf16(silu_f(a0[0]) * g0[0], silu_f(a0[1]) * g0[1]); w.y = cvt_pk_bf16(silu_f(a0[2]) * g0[2], silu_f(a0[3]) * g0[3]);
                w.z = cvt_pk_bf16(silu_f(a1[0]) * g1[0], silu_f(a1[1]) * g1[1]); w.w = cvt_pk_bf16(silu_f(a1[2]) * g1[2], silu_f(a1[3]) * g1[3]);
                st16_wt(rowp, w); }
    }
};
struct EpiRes {
    static constexpr bool PERM = true, AFTER_DRAIN = false;
    const float* xin_lo; const float* xin_hi;
    bf16_t* xb; const float* gate;
    __device__ __forceinline__ void operator()(const f32x4 (&acc)[2][2][4][2], const Unit& u, int wr, int wc, int fr_, int fq_) const {
        int fr = fr_, fq = fq_; asm volatile("" : "+v"(fr), "+v"(fq));
        const int rt = u.pm * BM; const int cond = rt < 8192 ? 0 : 1 + ((rt - 8192) >> 10);
        const int col0 = u.pn * BM + wc * 32 + 8 * fq; const float* g = gate + cond * 6144 + col0;
        bf16_t* dst = xb + (size_t)rt * 1024 + col0;
        f32x4 gv[2][2];
#pragma unroll
        for (int bj = 0; bj < 2; ++bj)
#pragma unroll
            for (int n = 0; n < 2; ++n) gv[bj][n] = *(const f32x4*)(g + bj * HALF + 4 * n);
        if (xin_lo != nullptr) {
            const float* src = (rt < 8192 ? xin_lo + (size_t)rt * 1024 : xin_hi + (size_t)(rt - 8192) * 1024) + col0;
#pragma unroll
            for (int am = 0; am < 8; ++am) {
                const int ai = am >> 2, m = am & 3; const size_t off = (size_t)(ai * HALF + wr * 64 + m * 16 + fr) * 1024;
                f32x4 xv[2][2];
#pragma unroll
                for (int bj = 0; bj < 2; ++bj)
#pragma unroll
                    for (int n = 0; n < 2; ++n) xv[bj][n] = *(const f32x4*)(src + off + bj * HALF + 4 * n);
#pragma unroll
                for (int bj = 0; bj < 2; ++bj) { const f32x4 v0 = xv[bj][0] + gv[bj][0] * acc[ai][bj][m][0], v1 = xv[bj][1] + gv[bj][1] * acc[ai][bj][m][1];
                    u32x4 w; w.x = cvt_pk_bf16(v0[0], v0[1]); w.y = cvt_pk_bf16(v0[2], v0[3]); w.z = cvt_pk_bf16(v1[0], v1[1]); w.w = cvt_pk_bf16(v1[2], v1[3]);
                    *(u32x4*)(dst + off + bj * HALF) = w; }
            }
        } else {
#pragma unroll
            for (int ai = 0; ai < 2; ++ai) {
                u32x4 xv[4][2];
#pragma unroll
                for (int m = 0; m < 4; ++m) { const size_t off = (size_t)(ai * HALF + wr * 64 + m * 16 + fr) * 1024;
#pragma unroll
                    for (int bj = 0; bj < 2; ++bj) xv[m][bj] = *(const u32x4*)(dst + off + bj * HALF); }
#pragma unroll
                for (int m = 0; m < 4; ++m) { const size_t off = (size_t)(ai * HALF + wr * 64 + m * 16 + fr) * 1024;
#pragma unroll
                    for (int bj = 0; bj < 2; ++bj) { const u32x4 x = xv[m][bj];
                        const f32x4 x0 = (f32x4){__uint_as_float(x.x << 16), __uint_as_float(x.x & 0xffff0000u), __uint_as_float(x.y << 16), __uint_as_float(x.y & 0xffff0000u)};
                        const f32x4 x1 = (f32x4){__uint_as_float(x.z << 16), __uint_as_float(x.z & 0xffff0000u), __uint_as_float(x.w << 16), __uint_as_float(x.w & 0xffff0000u)};
                        const f32x4 v0 = x0 + gv[bj][0] * acc[ai][bj][m][0], v1 = x1 + gv[bj][1] * acc[ai][bj][m][1];
                        u32x4 w; w.x = cvt_pk_bf16(v0[0], v0[1]); w.y = cvt_pk_bf16(v0[2], v0[3]); w.z = cvt_pk_bf16(v1[0], v1[1]); w.w = cvt_pk_bf16(v1[2], v1[3]);
                        *(u32x4*)(dst + off + bj * HALF) = w; } }
            }
        }
    }
};

template <class Epi, class Sched, bool ALIGN_EPI = false, bool SP2 = false>
__device__ __forceinline__ void gemm_phase(LAS unsigned char* lds, const Gemm g, const Sched& S, const Epi& E) {
    int tid_ = threadIdx.x; asm volatile("" : "+v"(tid_));
    const int tid = tid_, wid = __builtin_amdgcn_readfirstlane(tid >> 6), lane = tid & 63, wr = wid >> 2, wc = wid & 3, fr = lane & 15, fq = lane >> 4;
    const int K = g.K, nt = K / BK;
    unsigned voffA[2], voffB[2];
#pragma unroll
    for (int i = 0; i < 2; ++i) { int R, C; stage_rc(tid * 16 + i * 8192, R, C); const int Rb = Epi::PERM ? ((R & ~31) + perm32(R & 31)) : R;
        voffA[i] = (unsigned)(R * K + C) * 2u; voffB[i] = (unsigned)(Rb * K + C) * 2u; }
    const size_t kstep = (size_t)(BK * 2);
    const size_t hstep = (size_t)HALF * K * 2;
    const size_t tstep = 2 * hstep;
    const unsigned ldsw = (unsigned)wid * 1024u;
    const int aoff = lds_byte(wr * 64 + fr, fq * 8), boff = lds_byte(wc * 32 + fr, fq * 8);
#define PG8_SA(b, h) (((b) * 2 + (h)) * HTB)
#define PG8_SB(b, h) ((4 + (b) * 2 + (h)) * HTB)
#define PG8_STAGE(bufoff, gbase, voff) do { _Pragma("unroll") for (int _i = 0; _i < 2; ++_i) \
        __builtin_amdgcn_global_load_lds((const unsigned*)((const char*)(gbase) + (voff)[_i]), (LAS unsigned*)(lds + (bufoff) + ldsw + _i * 8192), 16, 0, 0); } while (0)
#define PG8_LDA(dst, b, h) do { _Pragma("unroll") for (int m = 0; m < 4; ++m) _Pragma("unroll") for (int k = 0; k < 2; ++k) dst[m][k] = *(const LAS bf16x8*)(lds + PG8_SA(b, h) + aoff + m * 2048 + k * 1024); } while (0)
#define PG8_LDB(dst, b, h) do { _Pragma("unroll") for (int n = 0; n < 2; ++n) _Pragma("unroll") for (int k = 0; k < 2; ++k) dst[n][k] = *(const LAS bf16x8*)(lds + PG8_SB(b, h) + boff + n * 2048 + k * 1024); } while (0)
#define PG8_MMA(ai, bj, At, Bt) do { __builtin_amdgcn_s_setprio(1); _Pragma("unroll") for (int m = 0; m < 4; ++m) _Pragma("unroll") for (int n = 0; n < 2; ++n) _Pragma("unroll") for (int k = 0; k < 2; ++k) \
        acc[ai][bj][m][n] = __builtin_amdgcn_mfma_f32_16x16x32_bf16(Bt[n][k], At[m][k], acc[ai][bj][m][n], 0, 0, 0); __builtin_amdgcn_s_setprio(0); } while (0)
#define PG8_WAIT_V(n) asm volatile("s_waitcnt vmcnt(" #n ")" ::: "memory")
#define PG8_WAIT_L(n) asm volatile("s_waitcnt lgkmcnt(" #n ")" ::: "memory")
#define PG8_BAR __builtin_amdgcn_s_barrier()
#define PG8_SCHED __builtin_amdgcn_sched_barrier(0)
    Unit cur, nxt; int ui = 0;
    if (!S.next(0, cur)) return;
    f32x4 acc[2][2][4][2];
#pragma unroll
    for (int a = 0; a < 2; ++a)
#pragma unroll
        for (int b = 0; b < 2; ++b)
#pragma unroll
            for (int m = 0; m < 4; ++m)
#pragma unroll
                for (int n = 0; n < 2; ++n) acc[a][b][m][n] = (f32x4){0.f, 0.f, 0.f, 0.f};
    bf16x8 At[4][2], B0[2][2], B1[2][2];
    const char* cA = (const char*)g.A + (size_t)cur.pm * tstep; const char* cB = (const char*)g.Bt + (size_t)cur.pn * tstep;
    S.a_ready(cur);
    if constexpr (SP2) {
        PG8_STAGE(PG8_SB(0, 0), cB, voffB); PG8_STAGE(PG8_SB(0, 1), cB + hstep, voffB); PG8_STAGE(PG8_SA(0, 0), cA, voffA); PG8_STAGE(PG8_SA(0, 1), cA + hstep, voffA);
        if (wr == 1) PG8_BAR;
        PG8_WAIT_V(2); PG8_BAR;
        PG8_STAGE(PG8_SB(1, 0), cB + kstep, voffB); PG8_STAGE(PG8_SA(1, 0), cA + kstep, voffA); PG8_STAGE(PG8_SB(1, 1), cB + hstep + kstep, voffB);
        PG8_WAIT_V(6); PG8_BAR;
    } else {
        PG8_STAGE(PG8_SB(0, 0), cB, voffB); PG8_STAGE(PG8_SA(0, 0), cA, voffA); PG8_STAGE(PG8_SB(0, 1), cB + hstep, voffB); PG8_STAGE(PG8_SA(0, 1), cA + hstep, voffA);
        if (wr == 1) PG8_BAR;
        PG8_WAIT_V(4); PG8_BAR;
        PG8_STAGE(PG8_SB(1, 0), cB + kstep, voffB); PG8_STAGE(PG8_SA(1, 0), cA + kstep, voffA); PG8_STAGE(PG8_SB(1, 1), cB + hstep + kstep, voffB);
        PG8_WAIT_V(6); PG8_BAR;
    }
    for (;;) {
        const bool has_next = S.next(ui + 1, nxt);
        const char* nA = has_next ? (const char*)g.A + (size_t)nxt.pm * tstep : cA; const char* nB = has_next ? (const char*)g.Bt + (size_t)nxt.pn * tstep : cB;
        for (int t = 0; t < nt; t += 2) {
            const bool last = (t == nt - 2);
            const char* a1 = cA + (size_t)(t + 1) * kstep;
            const char* a2 = last ? nA : cA + (size_t)(t + 2) * kstep; const char* b2 = last ? nB : cB + (size_t)(t + 2) * kstep;
            const char* a3 = a2 + kstep; const char* b3 = b2 + kstep;
            if (last && has_next) S.a_ready(nxt);
            if constexpr (SP2) {
            PG8_LDB(B0, 0, 0); PG8_LDB(B1, 0, 1); PG8_SCHED; PG8_LDA(At, 0, 0); PG8_STAGE(PG8_SA(1, 1), a1 + hstep, voffA);
            PG8_WAIT_V(8); PG8_WAIT_L(0); PG8_BAR; PG8_MMA(0, 0, At, B0); PG8_MMA(0, 1, At, B1); PG8_BAR; PG8_SCHED;
            PG8_LDA(At, 0, 1); PG8_STAGE(PG8_SB(0, 0), b2, voffB); PG8_STAGE(PG8_SB(0, 1), b2 + hstep, voffB); PG8_STAGE(PG8_SA(0, 0), a2, voffA);
            PG8_WAIT_V(8); PG8_WAIT_L(0); PG8_BAR; PG8_MMA(1, 0, At, B0); PG8_MMA(1, 1, At, B1); PG8_BAR; PG8_SCHED;
            PG8_LDB(B0, 1, 0); PG8_LDB(B1, 1, 1); PG8_SCHED; PG8_LDA(At, 1, 0); PG8_STAGE(PG8_SA(0, 1), a2 + hstep, voffA);
            PG8_WAIT_V(8); PG8_WAIT_L(0); PG8_BAR; PG8_MMA(0, 0, At, B0); PG8_MMA(0, 1, At, B1); PG8_BAR; PG8_SCHED;
            PG8_LDA(At, 1, 1); PG8_STAGE(PG8_SB(1, 0), b3, voffB); PG8_STAGE(PG8_SB(1, 1), b3 + hstep, voffB); PG8_STAGE(PG8_SA(1, 0), a3, voffA);
            PG8_WAIT_V(8); PG8_WAIT_L(0); PG8_BAR; PG8_MMA(1, 0, At, B0); PG8_MMA(1, 1, At, B1); PG8_BAR; PG8_SCHED;
            } else {
            PG8_LDB(B0, 0, 0); PG8_SCHED; PG8_LDA(At, 0, 0); PG8_STAGE(PG8_SA(1, 1), a1 + hstep, voffA);
            PG8_WAIT_L(8); PG8_BAR; PG8_WAIT_L(0); PG8_MMA(0, 0, At, B0); PG8_BAR; PG8_SCHED;
            PG8_LDB(B1, 0, 1); PG8_STAGE(PG8_SB(0, 0), b2, voffB);
            PG8_BAR; PG8_WAIT_L(0); PG8_MMA(0, 1, At, B1); PG8_BAR;
            PG8_LDA(At, 0, 1); PG8_STAGE(PG8_SA(0, 0), a2, voffA);
            PG8_BAR; PG8_WAIT_L(0); PG8_MMA(1, 0, At, B0); PG8_BAR; PG8_SCHED;
            PG8_STAGE(PG8_SB(0, 1), b2 + hstep, voffB);
            PG8_WAIT_V(6); PG8_BAR; PG8_MMA(1, 1, At, B1); PG8_BAR;
            PG8_LDB(B0, 1, 0); PG8_SCHED; PG8_LDA(At, 1, 0); PG8_STAGE(PG8_SA(0, 1), a2 + hstep, voffA);
            PG8_WAIT_L(8); PG8_BAR; PG8_WAIT_L(0); PG8_MMA(0, 0, At, B0); PG8_BAR; PG8_SCHED;
            PG8_LDB(B1, 1, 1); PG8_STAGE(PG8_SB(1, 0), b3, voffB);
            PG8_BAR; PG8_WAIT_L(0); PG8_MMA(0, 1, At, B1); PG8_BAR;
            PG8_LDA(At, 1, 1); PG8_STAGE(PG8_SA(1, 0), a3, voffA);
            PG8_BAR; PG8_WAIT_L(0); PG8_MMA(1, 0, At, B0); PG8_BAR; PG8_SCHED;
            PG8_STAGE(PG8_SB(1, 1), b3 + hstep, voffB);
            PG8_WAIT_V(6); PG8_BAR; PG8_MMA(1, 1, At, B1); PG8_BAR;
            }
        }
        if constexpr (ALIGN_EPI) { if (wr == 0) PG8_BAR; }
        if constexpr (!Epi::AFTER_DRAIN) { E(acc, cur, wr, wc, fr, fq); S.done(cur); }
        if (!has_next) break;
#pragma unroll
        for (int a = 0; a < 2; ++a)
#pragma unroll
            for (int b = 0; b < 2; ++b)
#pragma unroll
                for (int m = 0; m < 4; ++m)
#pragma unroll
                    for (int n = 0; n < 2; ++n) acc[a][b][m][n] = (f32x4){0.f, 0.f, 0.f, 0.f};
        cur = nxt; cA = nA; cB = nB; ++ui;
        if constexpr (ALIGN_EPI) { if (wr == 1) PG8_BAR; }
    }
    PG8_WAIT_V(0);
    if constexpr (!ALIGN_EPI) { if (wr == 0) PG8_BAR; }
    PG8_BAR;
#undef PG8_SA
#undef PG8_SB
#undef PG8_STAGE
#undef PG8_LDA
#undef PG8_LDB
#undef PG8_MMA
#undef PG8_WAIT_V
#undef PG8_WAIT_L
#undef PG8_BAR
#undef PG8_SCHED
}
}

constexpr int NWAVES = 8, NTHR = 512;
constexpr int DM = 1024, NTOK = 16384, NCTXR = 8192, DEPTH = 4;
constexpr int UP = 2816;
constexpr int DFF = 2816;
constexpr int U_XBC = 512, U_DT = 1280, U_RQ = 1296, U_RK = 1552, U_RV = 1808, U_RG = 2064, U_MQ = 2320, U_MKV = 2576, U_MKR = 2704;
constexpr int KVROWS = 8192 + 8 * 1536;
constexpr float EPS = 1e-6f;
constexpr int LDS_BYTES = 147456;

constexpr size_t MiB = 1u << 20;
constexpr size_t WS_MOD = 1 * MiB, WS_ROPE = 2 * MiB, WS_DT = 3 * MiB, WS_LA = 4 * MiB, WS_KR = 5 * MiB, WS_CKV = 7 * MiB, WS_QC = 12 * MiB,
                 WS_Q = 20 * MiB, WS_KV = 36 * MiB, WS_XBC = 56 * MiB, WS_YSSD = 80 * MiB, WS_YRET = 112 * MiB, WS_ABUF = 128 * MiB, WS_U = 160 * MiB, WS_W = 248 * MiB;
constexpr size_t WL_IN = 0, WL_OUT = WL_IN + (size_t)UP * 1024, WL_W1 = WL_OUT + 1024 * 1024, WL_W2 = WL_W1 + (size_t)5632 * 1024, WL_UQ = WL_W2 + (size_t)1024 * 2816,
                 WL_UKV = WL_UQ + 512 * 256, WL_TOTAL = WL_UKV + 512 * 128;
constexpr size_t WS_XB = 348 * MiB;
constexpr size_t WS_END = 380 * MiB;
static_assert(WS_W + 4 * WL_TOTAL * 2 <= WS_XB, "d_ws map");

constexpr size_t O_YP = 0, O_YS = 8388608, O_SSD = 16777216, O_RET = 25165824, O_CKV = 29360128, O_KR = 33554432;

struct Args { const float* in[29]; float* out; unsigned char* ws; int ph_lo, ph_hi; };

constexpr int PT_OFF = 140288;
__device__ __forceinline__ int fresh_tid() { int t = threadIdx.x; asm volatile("" : "+v"(t)); return t; }
#define TIDS const int tid = fresh_tid(), lane = tid & 63, wave = __builtin_amdgcn_readfirstlane(tid >> 6)
struct Ctx {
    LAS unsigned char* lds; int G, bid; float* out; unsigned char* ws;
    __device__ __forceinline__ const float* in(int k) const { const u32x2 v = *(const LAS u32x2*)(lds + PT_OFF + 8 * k);
        const unsigned lo = __builtin_amdgcn_readfirstlane(v.x), hi = __builtin_amdgcn_readfirstlane(v.y); return (const float*)(const GAS float*)(((unsigned long long)hi << 32) | lo); }
    __device__ __forceinline__ float* mod() const { return (float*)(ws + WS_MOD); }
    __device__ __forceinline__ float* ropec() const { return (float*)(ws + WS_ROPE); }
    __device__ __forceinline__ float* ropes() const { return (float*)(ws + WS_ROPE) + 1024 * 32; }
    __device__ __forceinline__ float* dtb() const { return (float*)(ws + WS_DT); }
    __device__ __forceinline__ float* lab() const { return (float*)(ws + WS_LA); }
    __device__ __forceinline__ bf16_t* krall() const { return (bf16_t*)(ws + WS_KR); }
    __device__ __forceinline__ bf16_t* ckvall() const { return (bf16_t*)(ws + WS_CKV); }
    __device__ __forceinline__ bf16_t* qc() const { return (bf16_t*)(ws + WS_QC); }
    __device__ __forceinline__ bf16_t* qb() const { return (bf16_t*)(ws + WS_Q); }
    __device__ __forceinline__ bf16_t* kvb() const { return (bf16_t*)(ws + WS_KV); }
    __device__ __forceinline__ bf16_t* xbc() const { return (bf16_t*)(ws + WS_XBC); }
    __device__ __forceinline__ bf16_t* yssd() const { return (bf16_t*)(ws + WS_YSSD); }
    __device__ __forceinline__ bf16_t* yret() const { return (bf16_t*)(ws + WS_YRET); }
    __device__ __forceinline__ bf16_t* abuf() const { return (bf16_t*)(ws + WS_ABUF); }
    __device__ __forceinline__ bf16_t* ub() const { return (bf16_t*)(ws + WS_U); }
    __device__ __forceinline__ bf16_t* wts() const { return (bf16_t*)(ws + WS_W); }
    __device__ __forceinline__ bf16_t* xb() const { return (bf16_t*)(ws + WS_XB); }
};

__device__ __forceinline__ float bf2f(unsigned v) { return __uint_as_float(v << 16); }
__device__ __forceinline__ float bflo(unsigned w) { return __uint_as_float(w << 16); }
__device__ __forceinline__ float bfhi(unsigned w) { return __uint_as_float(w & 0xffff0000u); }
__device__ __forceinline__ unsigned pk2(float lo, float hi) { return pg8::cvt_pk_bf16(lo, hi); }
template <int CTRL> __device__ __forceinline__ float dppf(float v) { return __builtin_bit_cast(float, __builtin_amdgcn_update_dpp(0, __builtin_bit_cast(int, v), CTRL, 0xf, 0xf, false)); }
__device__ __forceinline__ float row16_sum(float v) { v += dppf<0x128>(v); v += dppf<0x124>(v); v += dppf<0x122>(v); v += dppf<0x121>(v); return v; }
__device__ __forceinline__ float rlane(float v, int l) { return __builtin_bit_cast(float, __builtin_amdgcn_readlane(__builtin_bit_cast(int, v), l)); }
__device__ __forceinline__ float wave_sum(float v) { v = row16_sum(v); return (rlane(v, 0) + rlane(v, 16)) + (rlane(v, 32) + rlane(v, 48)); }
__device__ __forceinline__ int cond_of_row(int r) { return r < NCTXR ? 0 : 1 + ((r - NCTXR) >> 10); }
__device__ __forceinline__ int xcd_tile(int bid) { return (bid & 7) * 32 + (bid >> 3); }
__device__ __forceinline__ int xcd_row(int v, int G) { if (G != 256) return v; const int bid = (v & 2047) >> 3; return xcd_tile(bid) * 64 + (v >> 11) * 8 + (v & 7); }


template <int MODE>
__device__ __forceinline__ void transpose_item(const float* W, int K, int N, bf16_t* WT, LAS float* scr, int item, int lane, int nblk) {
    const int kb = item / nblk, nb = item % nblk, k0 = 64 * kb, n0 = 32 * nb;
    const int ks = lane >> 3, ns = lane & 7, nn = n0 + 4 * ns; const bool ok = nn < N;
    f32x4 v[8];
#pragma unroll
    for (int i = 0; i < 8; ++i) v[i] = ok ? __builtin_nontemporal_load((const f32x4*)(W + (size_t)(k0 + i * 8 + ks) * N + nn)) : (f32x4){0.f, 0.f, 0.f, 0.f};
#pragma unroll
    for (int i = 0; i < 8; ++i) { LAS float* d = scr + (i * 8 + ks) * 33 + 4 * ns; d[0] = v[i].x; d[1] = v[i].y; d[2] = v[i].z; d[3] = v[i].w; }
    asm volatile("s_waitcnt lgkmcnt(0)" ::: "memory");
    const int c = lane & 7;
#pragma unroll
    for (int j = 0; j < 4; ++j) { const int nl = (lane >> 3) + 8 * j; const int n = n0 + nl; const LAS float* s = scr + (8 * c) * 33 + nl;
        int row = n;
        if (MODE == 1) { const int jj = n < 2816 ? n : n - 2816; row = 256 * (jj >> 7) + (jj & 127) + (n < 2816 ? 0 : 128); }
        u32x4 o; o.x = pk2(s[0 * 33], s[1 * 33]); o.y = pk2(s[2 * 33], s[3 * 33]); o.z = pk2(s[4 * 33], s[5 * 33]); o.w = pk2(s[6 * 33], s[7 * 33]);
        *(u32x4*)(WT + (size_t)row * K + k0 + 8 * c) = o; }
    asm volatile("s_waitcnt lgkmcnt(0)" ::: "memory");
}

__device__ __forceinline__ void convert_weights(Ctx& C, int l, int widx, int nw, int wave, int lane, int which = 0) {
    LAS float* scr = (LAS float*)(C.lds + wave * 8448);
    constexpr int I_IN = 16 * 88, I_OUT = 16 * 32, I_W1 = 16 * 176, I_W2 = 44 * 32, I_UQ = 4 * 16, I_UKV = 2 * 16, I_L = I_IN + I_OUT + I_W1 + I_W2 + I_UQ + I_UKV;
    bf16_t* wl = C.wts() + (size_t)l * WL_TOTAL;
    for (int it = widx; it < I_L; it += nw) {
        int r = it;
        { const int cls = (r >= I_IN && r < I_IN + I_OUT + I_W1) ? 2 : (r >= I_IN + I_OUT + I_W1 && r < I_IN + I_OUT + I_W1 + I_W2) ? 3 : 1; if (which != 0 && cls != which) continue; }
        if (r < I_IN) { transpose_item<0>(C.in(11) + (size_t)l * 1024 * 2736, 1024, 2736, wl + WL_IN, scr, r, lane, 88); continue; } r -= I_IN;
        if (r < I_OUT) { transpose_item<0>(C.in(24) + (size_t)l * 1024 * 1024, 1024, 1024, wl + WL_OUT, scr, r, lane, 32); continue; } r -= I_OUT;
        if (r < I_W1) { transpose_item<1>(C.in(26) + (size_t)l * 1024 * 5632, 1024, 5632, wl + WL_W1, scr, r, lane, 176); continue; } r -= I_W1;
        if (r < I_W2) { transpose_item<0>(C.in(27) + (size_t)l * 2816 * 1024, 2816, 1024, wl + WL_W2, scr, r, lane, 32); continue; } r -= I_W2;
        if (r < I_UQ) { transpose_item<0>(C.in(21) + (size_t)l * 256 * 384, 256, 384, wl + WL_UQ, scr, r, lane, 16); continue; } r -= I_UQ;
        transpose_item<0>(C.in(23) + (size_t)l * 128 * 512, 128, 512, wl + WL_UKV, scr, r, lane, 16);
    }
}

__device__ __forceinline__ void phase_prologue(Ctx& C) {
    TIDS;
    for (int i = C.bid * NTHR + tid; i < 1024 * 32; i += C.G * NTHR) {
        const int t = i >> 5, d = i & 31, i8 = d & 7; const float pos = (float)((d < 16) ? (t >> 6) : (t & 63));
        const float inv = exp2f(-(float)i8 * 0.125f * 13.287712379549449f);
        const float ang = pos * inv;
        const float k = rintf(ang * 0.15915494309189535f);
        float rr = fmaf(-k, 6.28125f, ang); rr = fmaf(-k, 1.9353071795864769e-3f, rr);
        C.ropec()[i] = cosf(rr); C.ropes()[i] = sinf(rr);
    }
    if (C.bid < 192) {
        LAS float* sc = (LAS float*)(C.lds);
        LAS float* red = (LAS float*)(C.lds + 36 * 1024);
        const float* cctx = C.in(7); const float* cc = C.in(2);
        for (int i = tid; i < 9 * 1024; i += NTHR) { const int cnd = i >> 10, k = i & 1023; const float v = cnd == 0 ? cctx[k] : cc[(cnd - 1) * 1024 + k]; sc[i] = v / (1.0f + __expf(-v)); }
        __syncthreads();
        for (int task = C.bid; task < 192; task += C.G) {
            const int l = task / 48, col0 = (task % 48) * 128;
            const float* W = C.in(8) + (size_t)l * 1024 * 6144 + col0 + 2 * lane + (size_t)(wave * 128) * 6144;
            f32x2 a[9];
#pragma unroll
            for (int q = 0; q < 9; ++q) a[q] = (f32x2){0.f, 0.f};
            for (int k8 = 0; k8 < 128; k8 += 8) {
                f32x2 w[8];
#pragma unroll
                for (int e = 0; e < 8; ++e) w[e] = __builtin_nontemporal_load((const f32x2*)(W + (size_t)(k8 + e) * 6144));
#pragma unroll
                for (int q = 0; q < 9; ++q) { const f32x4 s0 = *(const LAS f32x4*)(sc + q * 1024 + wave * 128 + k8), s1 = *(const LAS f32x4*)(sc + q * 1024 + wave * 128 + k8 + 4);
                    a[q] += w[0] * s0.x; a[q] += w[1] * s0.y; a[q] += w[2] * s0.z; a[q] += w[3] * s0.w; a[q] += w[4] * s1.x; a[q] += w[5] * s1.y; a[q] += w[6] * s1.z; a[q] += w[7] * s1.w; }
            }
#pragma unroll
            for (int q = 0; q < 9; ++q) *(LAS f32x2*)(red + (wave * 9 + q) * 128 + 2 * lane) = a[q];
            __syncthreads();
            const float* bada = C.in(9);
            for (int o = tid; o < 9 * 128; o += NTHR) { const int q = o >> 7, c = o & 127; float sum = 0.f;
#pragma unroll
                for (int z = 0; z < 8; ++z) sum += red[(z * 9 + q) * 128 + c];
                C.mod()[((size_t)l * 9 + q) * 6144 + col0 + c] = sum + bada[(size_t)l * 6144 + col0 + c]; }
            __syncthreads();
        }
    }
    __syncthreads();
    convert_weights(C, 0, C.bid * NWAVES + wave, C.G * NWAVES, wave, lane, 1);
}

template <int MODE>
__device__ __forceinline__ void phase_norm(Ctx& C, const float* xlo, const float* xhi, const float* w, const float* modl, int sh_off, int sc_off) {
    TIDS;
    const int gw = C.bid * NWAVES + wave, NGW = C.G * NWAVES;
    f32x4 wv[4];
#pragma unroll
    for (int j = 0; j < 4; ++j) wv[j] = *(const f32x4*)(w + 4 * lane + 256 * j);
    for (int r0 = gw; r0 < NTOK; r0 += 2 * NGW) {
        f32x4 v[2][4]; int rr[2];
#pragma unroll
        for (int q = 0; q < 2; ++q) { const int r = xcd_row(r0 + q * NGW < NTOK ? r0 + q * NGW : r0, C.G); rr[q] = r;
            const float* xr = r < NCTXR ? xlo + (size_t)r * DM : xhi + (size_t)(r - NCTXR) * DM;
#pragma unroll
            for (int j = 0; j < 4; ++j) v[q][j] = *(const f32x4*)(xr + 4 * lane + 256 * j); }
#pragma unroll
        for (int q = 0; q < 2; ++q) { const int r = rr[q]; float s = 0.f;
#pragma unroll
            for (int j = 0; j < 4; ++j) s += (v[q][j].x * v[q][j].x + v[q][j].y * v[q][j].y) + (v[q][j].z * v[q][j].z + v[q][j].w * v[q][j].w);
            const float rstd = rsqrtf(wave_sum(s) * (1.f / DM) + EPS);
            if (MODE == 0) {
                const float* m = modl + cond_of_row(r) * 6144;
#pragma unroll
                for (int j = 0; j < 4; ++j) { const int c = 4 * lane + 256 * j; const f32x4 scv = *(const f32x4*)(m + sc_off + c), shv = *(const f32x4*)(m + sh_off + c);
                    const f32x4 h = v[q][j] * rstd * wv[j] * (scv + 1.0f) + shv;
                    u32x2 o; o.x = pk2(h.x, h.y); o.y = pk2(h.z, h.w); *(u32x2*)(C.abuf() + (size_t)r * DM + c) = o; }
            } else {
#pragma unroll
                for (int j = 0; j < 4; ++j) { const int c = 4 * lane + 256 * j; *(f32x4*)(C.out + (size_t)r * DM + c) = v[q][j] * rstd * wv[j]; }
            }
        }
    }
}

template <int MODE>
__device__ __forceinline__ void phase_norm_b(Ctx& C, const float* w, const float* modl, int sh_off, int sc_off) {
    TIDS;
    const int gw = C.bid * NWAVES + wave, NGW = C.G * NWAVES;
    f32x4 wv[2][2];
#pragma unroll
    for (int j = 0; j < 2; ++j) { wv[j][0] = *(const f32x4*)(w + 8 * lane + 512 * j); wv[j][1] = *(const f32x4*)(w + 8 * lane + 512 * j + 4); }
    for (int r0 = gw; r0 < NTOK; r0 += 4 * NGW) {
        u32x4 raw[4][2]; int rr[4];
#pragma unroll
        for (int q = 0; q < 4; ++q) { const int r = xcd_row(r0 + q * NGW < NTOK ? r0 + q * NGW : r0, C.G); rr[q] = r;
#pragma unroll
            for (int j = 0; j < 2; ++j) raw[q][j] = *(const u32x4*)(C.xb() + (size_t)r * DM + 8 * lane + 512 * j); }
#pragma unroll
        for (int q = 0; q < 4; ++q) { const int r = rr[q]; f32x4 v[2][2]; float s = 0.f;
#pragma unroll
            for (int j = 0; j < 2; ++j) { const u32x4 x = raw[q][j]; v[j][0] = (f32x4){bflo(x.x), bfhi(x.x), bflo(x.y), bfhi(x.y)}; v[j][1] = (f32x4){bflo(x.z), bfhi(x.z), bflo(x.w), bfhi(x.w)};
#pragma unroll
                for (int hh = 0; hh < 2; ++hh) s += (v[j][hh].x * v[j][hh].x + v[j][hh].y * v[j][hh].y) + (v[j][hh].z * v[j][hh].z + v[j][hh].w * v[j][hh].w); }
            const float rstd = rsqrtf(wave_sum(s) * (1.f / DM) + EPS);
            if (MODE == 0) {
                const float* m = modl + cond_of_row(r) * 6144;
#pragma unroll
                for (int j = 0; j < 2; ++j) { const int c = 8 * lane + 512 * j; f32x4 h[2];
#pragma unroll
                    for (int hh = 0; hh < 2; ++hh) { const f32x4 scv = *(const f32x4*)(m + sc_off + c + 4 * hh), shv = *(const f32x4*)(m + sh_off + c + 4 * hh); h[hh] = v[j][hh] * rstd * wv[j][hh] * (scv + 1.0f) + shv; }
                    u32x4 o; o.x = pk2(h[0].x, h[0].y); o.y = pk2(h[0].z, h[0].w); o.z = pk2(h[1].x, h[1].y); o.w = pk2(h[1].z, h[1].w); *(u32x4*)(C.abuf() + (size_t)r * DM + c) = o; }
            } else {
#pragma unroll
                for (int j = 0; j < 2; ++j) { const int c = 8 * lane + 512 * j;
#pragma unroll
                    for (int hh = 0; hh < 2; ++hh) *(f32x4*)(C.out + (size_t)r * DM + c + 4 * hh) = v[j][hh] * rstd * wv[j][hh]; }
            }
        }
    }
}

#define MFMA16P(x, y, c) __builtin_amdgcn_mfma_f32_16x16x32_bf16((x), (y), (c), 0, 0, 0)
constexpr int PP_QC = 0, PP_CKV = 33792;
__device__ __forceinline__ void phase_prep(Ctx& C, int layer) {
    TIDS; const int fr = lane & 15, fq = lane >> 4;
    LAS bf16_t* sQC = (LAS bf16_t*)(C.lds + PP_QC); LAS bf16_t* sCKV = (LAS bf16_t*)(C.lds + PP_CKV);
    const float* cw = C.in(12) + (size_t)layer * 5 * 768; const float* cb = C.in(13) + (size_t)layer * 768;
    const f32x4 qnw = *(const f32x4*)(C.in(20) + layer * 256 + 4 * lane); const f32x2 kvnw = *(const f32x2*)(C.in(22) + layer * 128 + 2 * lane);
    const float dtbias = C.in(14)[layer * 16 + (lane & 15)], aexp = __expf(C.in(15)[layer * 16 + (lane & 15)]);
    const bf16_t* wl = C.wts() + (size_t)layer * WL_TOTAL;
    for (int tile_ = C.bid; tile_ < NTOK / 64; tile_ += C.G) { const int tile = C.G == 256 ? xcd_tile(tile_) : tile_;
        __syncthreads();
        f32x2 cv[2], ck[2];
#pragma unroll
        for (int q = 0; q < 2; ++q) { const int idx = 16 * tile + 2 * wave + q, b = idx >> 9, sx = idx & 511;
            cv[q] = *(const f32x2*)(C.in(5) + (((size_t)b * DEPTH + layer) * 512 + sx) * 128 + 2 * lane);
            ck[q] = *(const f32x2*)(C.in(6) + (((size_t)b * DEPTH + layer) * 512 + sx) * 32 + 2 * (lane & 15)); }
        const int r0 = tile * 64 + wave * 8; const bool ctx = r0 < NCTXR; const int b = ctx ? (r0 >> 8) : ((r0 - NCTXR) >> 10), t0 = ctx ? (r0 & 255) : ((r0 - NCTXR) & 1023), L = ctx ? 256 : 1024;
        const bf16_t* u0 = C.ub() + (size_t)r0 * UP;
        unsigned rdt[8]; u32x2 rq[8]; unsigned rkv[8]; unsigned rkr[8];
#pragma unroll
        for (int j = 0; j < 8; ++j) { const bf16_t* ur = u0 + (size_t)j * UP; rdt[j] = ur[U_DT + (lane & 15)]; rq[j] = *(const u32x2*)(ur + U_MQ + 4 * lane); rkv[j] = *(const unsigned*)(ur + U_MKV + 2 * lane); rkr[j] = ur[U_MKR + (lane & 31)]; }
        {
            int lane_ = lane; asm volatile("" : "+v"(lane_)); const int lane = lane_;
            u32x2 raw[12][3];
#pragma unroll
            for (int j = 0; j < 12; ++j) { const int tt = t0 + j - 2; const bool ok = tt >= 0 && tt < L;
#pragma unroll
                for (int c3 = 0; c3 < 3; ++c3) raw[j][c3] = ok ? *(const u32x2*)((u0 - 2 * UP) + (unsigned)(j * UP + U_XBC + 4 * lane + 256 * c3)) : (u32x2){0u, 0u}; }
#pragma unroll
            for (int c3 = 0; c3 < 3; ++c3) { const unsigned ch = 4 * lane + 256 * c3; const f32x4 bias = *(const f32x4*)(cb + ch); f32x4 wv[5];
#pragma unroll
                for (int w = 0; w < 5; ++w) wv[w] = *(const f32x4*)(cw + (w * 768u + ch));
#pragma unroll
                for (int j = 0; j < 8; ++j) { f32x4 acc = bias;
#pragma unroll
                    for (int w = 0; w < 5; ++w) { const u32x2 rw = raw[j + w][c3]; acc.x += bflo(rw.x) * wv[w].x; acc.y += bfhi(rw.x) * wv[w].y; acc.z += bflo(rw.y) * wv[w].z; acc.w += bfhi(rw.y) * wv[w].w; }
                    u32x2 o; o.x = pk2(pg8::silu_f(acc.x), pg8::silu_f(acc.y)); o.y = pk2(pg8::silu_f(acc.z), pg8::silu_f(acc.w)); *(u32x2*)((C.xbc() + (size_t)(r0 + j) * 768) + ch) = o; } }
        }
        { int lane_ = lane; asm volatile("" : "+v"(lane_)); const int lane = lane_;
#pragma unroll
        for (int q = 0; q < 2; ++q) { const int idx = 16 * tile + 2 * wave + q, b = idx >> 9, sx = idx & 511; const size_t krow = 8192 + (size_t)b * 1536 + sx;
            *(LAS unsigned*)(sCKV + (64 + 2 * wave + q) * 136 + 2 * lane) = pk2(cv[q].x, cv[q].y);
            if (lane < 16) *(unsigned*)(C.krall() + krow * 32 + 2 * lane) = pk2(ck[q].x, ck[q].y); }
#pragma unroll
        for (int j = 0; j < 8; ++j) { const int r = r0 + j, t = t0 + j;
            if (lane < 16) { const float v = bf2f(rdt[j]) + dtbias; const float dt = v > 20.f ? v : 0.6931471805599453f * __builtin_amdgcn_logf(1.0f + __builtin_amdgcn_exp2f(1.4426950408889634f * v)); C.dtb()[(size_t)r * 16 + lane] = dt; C.lab()[(size_t)r * 16 + lane] = -dt * aexp; }
            { const float x0 = bflo(rq[j].x), x1 = bfhi(rq[j].x), x2 = bflo(rq[j].y), x3 = bfhi(rq[j].y);
              const float rstd = rsqrtf(wave_sum(x0 * x0 + x1 * x1 + x2 * x2 + x3 * x3) * (1.f / 256) + EPS);
              u32x2 o; o.x = pk2(x0 * rstd * qnw.x, x1 * rstd * qnw.y); o.y = pk2(x2 * rstd * qnw.z, x3 * rstd * qnw.w); *(LAS u32x2*)(sQC + (wave * 8 + j) * 264 + 4 * lane) = o; }
            const size_t krow = ctx ? (size_t)r : 8192 + (size_t)b * 1536 + 512 + t;
            { const float x0 = bflo(rkv[j]), x1 = bfhi(rkv[j]); const float rstd = rsqrtf(wave_sum(x0 * x0 + x1 * x1) * (1.f / 128) + EPS);
              const float y0 = x0 * rstd * kvnw.x, y1 = x1 * rstd * kvnw.y; *(LAS unsigned*)(sCKV + (wave * 8 + j) * 136 + 2 * lane) = pk2(y0, y1);
              if (ctx) *(f32x2*)(C.out + O_CKV + (((size_t)b * DEPTH + layer) * 256 + t) * 128 + 2 * lane) = (f32x2){y0, y1}; }
            { const float v = bf2f(rkr[j]); const float partner = dppf<0x128>(v); float o = v;
              if (!ctx) { const float rot = (lane & 8) ? partner : -partner; o = v * C.ropec()[t * 32 + (lane & 31)] + rot * C.ropes()[t * 32 + (lane & 31)]; }
              if (lane < 32) { C.krall()[krow * 32 + lane] = (bf16_t)(pk2(o, 0.f) & 0xffffu); if (ctx) C.out[O_KR + (((size_t)b * DEPTH + layer) * 256 + t) * 32 + lane] = v; } }
        }
        }
        __syncthreads();
        __builtin_amdgcn_sched_barrier(0);
        {
            int lane_ = lane; asm volatile("" : "+v"(lane_)); const int fr = lane_ & 15, fq = lane_ >> 4;
            const bf16_t* Bq = wl + WL_UQ + (unsigned)((48 * wave + fr) * 256 + fq * 8);
            f32x4 acc[4][3];
#pragma unroll
            for (int mt = 0; mt < 4; ++mt)
#pragma unroll
                for (int j = 0; j < 3; ++j) acc[mt][j] = (f32x4){0.f, 0.f, 0.f, 0.f};
#pragma unroll
            for (int kh = 0; kh < 2; ++kh) {
                bf16x8 xq[3][4];
#pragma unroll
                for (int j = 0; j < 3; ++j)
#pragma unroll
                    for (int k4 = 0; k4 < 4; ++k4) xq[j][k4] = *(const bf16x8*)(Bq + (j * 16 * 256 + (4 * kh + k4) * 32));
                __builtin_amdgcn_sched_barrier(0);
#pragma unroll
                for (int k4 = 0; k4 < 4; ++k4) { const int kk = 4 * kh + k4; bf16x8 ya[4];
#pragma unroll
                    for (int mt = 0; mt < 4; ++mt) ya[mt] = *(const LAS bf16x8*)(sQC + (16 * mt + fr) * 264 + kk * 32 + fq * 8);
#pragma unroll
                    for (int mt = 0; mt < 4; ++mt)
#pragma unroll
                        for (int j = 0; j < 3; ++j) acc[mt][j] = MFMA16P(xq[j][k4], ya[mt], acc[mt][j]); }
                __builtin_amdgcn_sched_barrier(0);
            }
#pragma unroll
            for (int mt = 0; mt < 4; ++mt) { bf16_t* qrow = C.qb() + (unsigned)((tile * 64 + 16 * mt + fr) * 512 + 48 * wave + 4 * fq);
#pragma unroll
                for (int j = 0; j < 3; ++j) { u32x2 o; o.x = pk2(acc[mt][j][0], acc[mt][j][1]); o.y = pk2(acc[mt][j][2], acc[mt][j][3]); *(u32x2*)(qrow + 16 * j) = o; } }
        }
        {
            __builtin_amdgcn_sched_barrier(0);
            int lane_ = lane; asm volatile("" : "+v"(lane_)); const int fr = lane_ & 15, fq = lane_ >> 4;
            const bf16_t* Bk = wl + WL_UKV + (unsigned)((64 * wave + fr) * 128 + fq * 8);
            bf16x8 xk[4][4];
#pragma unroll
            for (int j = 0; j < 4; ++j)
#pragma unroll
                for (int kk = 0; kk < 4; ++kk) xk[j][kk] = *(const bf16x8*)(Bk + (j * 16 * 128 + kk * 32));
            f32x4 acc[5][4];
#pragma unroll
            for (int mt = 0; mt < 5; ++mt)
#pragma unroll
                for (int j = 0; j < 4; ++j) acc[mt][j] = (f32x4){0.f, 0.f, 0.f, 0.f};
#pragma unroll
            for (int kk = 0; kk < 4; ++kk) { bf16x8 ya[5];
#pragma unroll
                for (int mt = 0; mt < 5; ++mt) ya[mt] = *(const LAS bf16x8*)(sCKV + (16 * mt + fr) * 136 + kk * 32 + fq * 8);
#pragma unroll
                for (int mt = 0; mt < 5; ++mt)
#pragma unroll
                    for (int j = 0; j < 4; ++j) acc[mt][j] = MFMA16P(xk[j][kk], ya[mt], acc[mt][j]); }
#pragma unroll
            for (int mt = 0; mt < 5; ++mt) { unsigned krow;
                if (mt < 4) { const int r = tile * 64 + 16 * mt + fr; krow = r < NCTXR ? (unsigned)r : 8192u + (unsigned)(((r - NCTXR) >> 10) * 1536 + 512 + ((r - NCTXR) & 1023)); }
                else { const int idx = 16 * tile + fr; krow = 8192u + (unsigned)((idx >> 9) * 1536 + (idx & 511)); }
                bf16_t* kvrow = C.kvb() + (krow * 512u + (unsigned)(64 * wave + 4 * fq));
#pragma unroll
                for (int j = 0; j < 4; ++j) { u32x2 o; o.x = pk2(acc[mt][j][0], acc[mt][j][1]); o.y = pk2(acc[mt][j][2], acc[mt][j][3]); *(u32x2*)(kvrow + 16 * j) = o; } }
        }
    }
}

#define LDS_BARRIER() do { asm volatile("s_waitcnt lgkmcnt(0)" ::: "memory"); __builtin_amdgcn_s_barrier(); asm volatile("" ::: "memory"); } while (0)
#define SCHED_FENCE() __builtin_amdgcn_sched_barrier(0)
#define MFMA16(x, y, c) __builtin_amdgcn_mfma_f32_16x16x32_bf16((x), (y), (c), 0, 0, 0)
constexpr int SC_Q = 0, SC_K = 18432, SC_KT = 36864, SC_VT = 54272, SC_P = 71680, SC_Q2 = 106496, SC_HT = 124928, SC_CUM = 134144, SC_LA = 134656, SC_DT = 135168;

__device__ __forceinline__ void scan_unit(Ctx& C, int layer, int kind  , bool ctx, int b, int h, int dir) {
    LAS unsigned char* lds = C.lds;
    TIDS; const int wid = wave, fr = lane & 15, fq = lane >> 4;
    const int L = ctx ? 256 : 1024, R0 = ctx ? b * 256 : NCTXR + b * 1024, nch = L >> 7;
    const bf16_t *qp, *kp, *vp; int pitch; float kscale, la_const = 0.f; bf16_t* yout; int ypitch; int NH;
    if (kind == 0) { const int g = h >> 2; qp = C.xbc() + 640 + g * 64; kp = C.xbc() + 512 + g * 64; vp = C.xbc() + h * 64; pitch = 768; kscale = 1.f;
        yout = C.yssd() + (size_t)dir * NTOK * 512 + h * 64; ypitch = 512; NH = 8; }
    else { qp = C.ub() + U_RQ + h * 64; kp = C.ub() + U_RK + h * 64; vp = C.ub() + U_RV + h * 64; pitch = UP; kscale = 0.125f;
        const float x = C.in(18)[layer * 8 + dir * 4 + h]; la_const = -log1pf(__expf(-x));
        yout = C.yret() + (size_t)dir * NTOK * 256 + h * 64; ypitch = 256; NH = 4; }
    const float* labp = C.lab() + dir * 8 + h; const float* dtbp = C.dtb() + dir * 8 + h;
    LAS bf16_t* sQ = (LAS bf16_t*)(lds + SC_Q); LAS bf16_t* sK = (LAS bf16_t*)(lds + SC_K); LAS bf16_t* sKT = (LAS bf16_t*)(lds + SC_KT); LAS bf16_t* sVT = (LAS bf16_t*)(lds + SC_VT);
    LAS bf16_t* sP = (LAS bf16_t*)(lds + SC_P); LAS bf16_t* sQ2 = (LAS bf16_t*)(lds + SC_Q2); LAS bf16_t* sHT = (LAS bf16_t*)(lds + SC_HT);
    LAS float* sCumAll = (LAS float*)(lds + SC_CUM);
    const int tn = wid >> 1, tp0 = (wid & 1) * 2;
    f32x4 Hacc[2];
    if (!ctx) { const float* st = (kind == 0 ? C.in(3) : C.in(4)) + ((((size_t)b * DEPTH + layer) * 2 + dir) * NH + h) * 4096;
#pragma unroll
        for (int q = 0; q < 2; ++q)
#pragma unroll
            for (int e = 0; e < 4; ++e) Hacc[q][e] = __builtin_nontemporal_load(st + (16 * tn + 4 * fq + e) * 64 + 16 * (tp0 + q) + fr); }
    else { Hacc[0] = (f32x4){0.f, 0.f, 0.f, 0.f}; Hacc[1] = Hacc[0]; }
    const int li = tid >> 3, p8 = tid & 7;
    u32x4 qv[2], kv[2], vv[2]; float dt_r[2];
#define SCAN_ISSUE(cc) do { _Pragma("unroll") for (int ps_ = 0; ps_ < 2; ++ps_) { const int pos_ = (cc) * 128 + li + 64 * ps_, t_ = dir ? L - 1 - pos_ : pos_; const size_t r_ = (size_t)(R0 + t_); \
        qv[ps_] = *(const u32x4*)(qp + r_ * pitch + p8 * 8); kv[ps_] = *(const u32x4*)(kp + r_ * pitch + p8 * 8); vv[ps_] = *(const u32x4*)(vp + r_ * pitch + p8 * 8); \
        dt_r[ps_] = kind == 0 ? dtbp[r_ * 16] : 1.0f; } } while (0)
    float cs_e = 0.f, cs_o = 0.f;
    if (wid < nch) { float a[2];
#pragma unroll
        for (int e = 0; e < 2; ++e) { const int pos = wid * 128 + 2 * lane + e, t = dir ? L - 1 - pos : pos; a[e] = (kind == 0 ? labp[(size_t)(R0 + t) * 16] : la_const) * 1.4426950408889634f; }
        float sc = a[0] + a[1];
#pragma unroll
        for (int o = 1; o < 64; o <<= 1) { const float v = __shfl_up(sc, o); if (lane >= o) sc += v; }
        cs_o = sc; cs_e = sc - a[1]; }
    SCAN_ISSUE(0);
    __syncthreads();
#pragma unroll
    for (int q = 0; q < 2; ++q) { u32x2 o; o.x = pk2(Hacc[q][0], Hacc[q][1]); o.y = pk2(Hacc[q][2], Hacc[q][3]); *(LAS u32x2*)(sHT + (16 * (tp0 + q) + fr) * 72 + 16 * tn + 4 * fq) = o; }
    if (wid < nch) *(LAS f32x2*)(sCumAll + wid * 128 + 2 * lane) = (f32x2){cs_e, cs_o};
    __syncthreads();
    for (int c = 0; c < nch; ++c) {
        const LAS float* sCum = sCumAll + c * 128;
        float cum_i[2]; const float cum_last = sCum[127];
#pragma unroll
        for (int ps = 0; ps < 2; ++ps) cum_i[ps] = sCum[li + 64 * ps];
#pragma unroll
        for (int ps = 0; ps < 2; ++ps) {
            const int i = li + 64 * ps, isw = i ^ (8 * p8);
            const float te = __builtin_amdgcn_exp2f(cum_last - cum_i[ps]) * kscale, dtv = dt_r[ps];
            *(LAS u32x4*)(sQ + i * 72 + p8 * 8) = qv[ps]; *(LAS u32x4*)(sK + i * 72 + p8 * 8) = kv[ps];
            const unsigned ka[4] = {kv[ps].x, kv[ps].y, kv[ps].z, kv[ps].w}, va[4] = {vv[ps].x, vv[ps].y, vv[ps].z, vv[ps].w};
#pragma unroll
            for (int e = 0; e < 4; ++e) {
                const unsigned kt = pk2(bflo(ka[e]) * te, bfhi(ka[e]) * te), vt = pk2(bflo(va[e]) * dtv, bfhi(va[e]) * dtv);
                sKT[(p8 * 8 + 2 * e) * 136 + isw] = (bf16_t)(kt & 0xffffu); sKT[(p8 * 8 + 2 * e + 1) * 136 + isw] = (bf16_t)(kt >> 16);
                sVT[(p8 * 8 + 2 * e) * 136 + isw] = (bf16_t)(vt & 0xffffu); sVT[(p8 * 8 + 2 * e + 1) * 136 + isw] = (bf16_t)(vt >> 16); }
        }
        if (c + 1 < nch) SCAN_ISSUE(c + 1);
        LDS_BARRIER();
        {
            const float kadj = kind == 0 ? 0.f : -3.f;
            int prt[5], pjt[5];
#pragma unroll
            for (int t = 0; t < 5; ++t) { const int p = wid + 8 * t; int rt = 0;
#pragma unroll
                for (int k = 1; k < 8; ++k) if (p >= k * (k + 1) / 2) rt = k;
                prt[t] = rt; pjt[t] = p - rt * (rt + 1) / 2; }
            {
                bf16x8 yq[4][2], xk[4][2]; f32x4 cj[4], s4[4]; float cumr[4];
#pragma unroll
                for (int t = 0; t < 4; ++t) { const int i = 16 * prt[t] + fr, jr = 16 * pjt[t] + fr;
                    yq[t][0] = *(const LAS bf16x8*)(sQ + i * 72 + fq * 8); yq[t][1] = *(const LAS bf16x8*)(sQ + i * 72 + 32 + fq * 8);
                    xk[t][0] = *(const LAS bf16x8*)(sK + jr * 72 + fq * 8); xk[t][1] = *(const LAS bf16x8*)(sK + jr * 72 + 32 + fq * 8);
                    cj[t] = *(const LAS f32x4*)(sCum + 16 * pjt[t] + 4 * fq); cumr[t] = sCum[i] + kadj; }
                SCHED_FENCE();
#pragma unroll
                for (int t = 0; t < 4; ++t) s4[t] = MFMA16(xk[t][0], yq[t][0], ((f32x4){0.f, 0.f, 0.f, 0.f}));
#pragma unroll
                for (int t = 0; t < 4; ++t) s4[t] = MFMA16(xk[t][1], yq[t][1], s4[t]);
                SCHED_FENCE();
#pragma unroll
                for (int t = 0; t < 4; ++t) { const int i = 16 * prt[t] + fr; float pv[4];
                    if (prt[t] == pjt[t]) {
#pragma unroll
                        for (int e = 0; e < 4; ++e) { const int j = 16 * pjt[t] + 4 * fq + e; pv[e] = s4[t][e] * __builtin_amdgcn_exp2f(j <= i ? cumr[t] - cj[t][e] : -1e30f); } }
                    else {
#pragma unroll
                        for (int e = 0; e < 4; ++e) pv[e] = s4[t][e] * __builtin_amdgcn_exp2f(cumr[t] - cj[t][e]); }
                    u32x2 o; o.x = pk2(pv[0], pv[1]); o.y = pk2(pv[2], pv[3]); *(LAS u32x2*)(sP + i * 136 + 16 * pjt[t] + 4 * fq) = o; }
            }
            if (wid < 4) {
                const int i = 16 * prt[4] + fr, jr = 16 * pjt[4] + fr;
                const bf16x8 y0 = *(const LAS bf16x8*)(sQ + i * 72 + fq * 8), y1 = *(const LAS bf16x8*)(sQ + i * 72 + 32 + fq * 8);
                const bf16x8 x0 = *(const LAS bf16x8*)(sK + jr * 72 + fq * 8), x1 = *(const LAS bf16x8*)(sK + jr * 72 + 32 + fq * 8);
                const f32x4 cj = *(const LAS f32x4*)(sCum + 16 * pjt[4] + 4 * fq); const float cumr = sCum[i] + kadj;
                f32x4 s4 = MFMA16(x0, y0, ((f32x4){0.f, 0.f, 0.f, 0.f})); s4 = MFMA16(x1, y1, s4);
                float pv[4];
#pragma unroll
                for (int e = 0; e < 4; ++e) { const int j = 16 * pjt[4] + 4 * fq + e; pv[e] = s4[e] * __builtin_amdgcn_exp2f(j <= i ? cumr - cj[e] : -1e30f); }
                u32x2 o; o.x = pk2(pv[0], pv[1]); o.y = pk2(pv[2], pv[3]); *(LAS u32x2*)(sP + i * 136 + 16 * pjt[4] + 4 * fq) = o;
            } else {
                const int rt = 2 * (wid - 4); *(LAS u32x2*)(sP + (16 * rt + fr) * 136 + 16 * (rt + 1) + 4 * fq) = (u32x2){0u, 0u};
            }
        }
        LDS_BARRIER();
        {
            const int i = 16 * wid + fr; f32x4 acc[4];
            {
                bf16x8 yq[2], xh[2][4], yp, xv[4]; f32x4 ah[4];
#pragma unroll
                for (int kk = 0; kk < 2; ++kk) { yq[kk] = *(const LAS bf16x8*)(sQ + i * 72 + kk * 32 + fq * 8);
#pragma unroll
                    for (int pt = 0; pt < 4; ++pt) xh[kk][pt] = *(const LAS bf16x8*)(sHT + (16 * pt + fr) * 72 + kk * 32 + fq * 8); }
                yp = *(const LAS bf16x8*)(sP + i * 136 + fq * 8);
#pragma unroll
                for (int pt = 0; pt < 4; ++pt) xv[pt] = *(const LAS bf16x8*)(sVT + (16 * pt + fr) * 136 + ((fq * 8) ^ (8 * ((2 * pt + (fr >> 3)) & 7))));
                const float ecr = __builtin_amdgcn_exp2f(sCum[i]);
                SCHED_FENCE();
#pragma unroll
                for (int pt = 0; pt < 4; ++pt) ah[pt] = MFMA16(xh[0][pt], yq[0], ((f32x4){0.f, 0.f, 0.f, 0.f}));
#pragma unroll
                for (int pt = 0; pt < 4; ++pt) acc[pt] = MFMA16(xv[pt], yp, ((f32x4){0.f, 0.f, 0.f, 0.f}));
#pragma unroll
                for (int pt = 0; pt < 4; ++pt) ah[pt] = MFMA16(xh[1][pt], yq[1], ah[pt]);
                SCHED_FENCE();
#pragma unroll
                for (int pt = 0; pt < 4; ++pt) acc[pt] = acc[pt] + ah[pt] * ecr;
            }
#define SCAN_PV_STEP(kk_) do { bf16x8 yp_ = *(const LAS bf16x8*)(sP + i * 136 + (kk_) * 32 + fq * 8); bf16x8 xv_[4]; \
                _Pragma("unroll") for (int pt = 0; pt < 4; ++pt) xv_[pt] = *(const LAS bf16x8*)(sVT + (16 * pt + fr) * 136 + (((kk_) * 32 + fq * 8) ^ (8 * ((2 * pt + (fr >> 3)) & 7)))); \
                SCHED_FENCE(); \
                _Pragma("unroll") for (int pt = 0; pt < 4; ++pt) acc[pt] = MFMA16(xv_[pt], yp_, acc[pt]); \
                SCHED_FENCE(); } while (0)
            if (wid >= 2) SCAN_PV_STEP(1);
            if (wid >= 4) SCAN_PV_STEP(2);
            if (wid >= 6) SCAN_PV_STEP(3);
#undef SCAN_PV_STEP
            const int pos = c * 128 + i, t = dir ? L - 1 - pos : pos; bf16_t* yr = yout + (size_t)(R0 + t) * ypitch;
#pragma unroll
            for (int pt = 0; pt < 4; ++pt) { u32x2 o; o.x = pk2(acc[pt][0], acc[pt][1]); o.y = pk2(acc[pt][2], acc[pt][3]); *(u32x2*)(yr + 16 * pt + 4 * fq) = o; }
        }
        {
            const float dec = __builtin_amdgcn_exp2f(cum_last);
            bf16x8 xk[4], yv[2][4];
#pragma unroll
            for (int kk = 0; kk < 4; ++kk) { xk[kk] = *(const LAS bf16x8*)(sKT + (16 * tn + fr) * 136 + ((kk * 32 + fq * 8) ^ (8 * ((2 * tn + (fr >> 3)) & 7))));
#pragma unroll
                for (int q = 0; q < 2; ++q) yv[q][kk] = *(const LAS bf16x8*)(sVT + (16 * (tp0 + q) + fr) * 136 + ((kk * 32 + fq * 8) ^ (8 * ((2 * (tp0 + q) + (fr >> 3)) & 7)))); }
            Hacc[0] = Hacc[0] * dec; Hacc[1] = Hacc[1] * dec;
            SCHED_FENCE();
#pragma unroll
            for (int kk = 0; kk < 4; ++kk)
#pragma unroll
                for (int q = 0; q < 2; ++q) Hacc[q] = MFMA16(xk[kk], yv[q][kk], Hacc[q]);
            SCHED_FENCE();
        }
        LDS_BARRIER();
#pragma unroll
        for (int q = 0; q < 2; ++q) { u32x2 o; o.x = pk2(Hacc[q][0], Hacc[q][1]); o.y = pk2(Hacc[q][2], Hacc[q][3]); *(LAS u32x2*)(sHT + (16 * (tp0 + q) + fr) * 72 + 16 * tn + 4 * fq) = o; }
    }
#undef SCAN_ISSUE
    if (ctx) { float* so = C.out + (kind == 0 ? O_SSD : O_RET) + ((((size_t)b * DEPTH + layer) * 2 + dir) * NH + h) * 4096;
#pragma unroll
        for (int q = 0; q < 2; ++q)
#pragma unroll
            for (int e = 0; e < 4; ++e) so[(16 * tn + 4 * fq + e) * 64 + 16 * (tp0 + q) + fr] = Hacc[q][e]; }
}

constexpr int AT_K = 0, AT_VT = 26624, AT_BUF = 44032;
template <int MODE = 0>
__device__ __forceinline__ void attn_unit(Ctx& C, bool ctx, int b, int h, int qb) {
    LAS unsigned char* lds = C.lds;
    TIDS; const int wid = wave, fr = lane & 15, fq = lane >> 4;
    const int R0 = ctx ? b * 256 : NCTXR + b * 1024, KR0 = ctx ? b * 256 : 8192 + b * 1536, S = ctx ? 256 : 1536, nkt = S >> 7;
    const int tq = qb * 128 + 16 * wid + fr; const size_t rq = (size_t)(R0 + tq);
    const float SCL = 0.10206207261596577f * 1.4426950408889634f;
    const int lj = tid >> 3, p8 = tid & 7, rj = tid >> 2, rp = tid & 3;
    const bf16_t* kvbase = C.kvb() + (size_t)(KR0 + lj) * 512 + h * 128 + p8 * 8; const bf16_t* krbase = C.krall() + (size_t)(KR0 + rj) * 32 + rp * 8;
    u32x4 kn[2], vn[2], kr8;
#define ATT_ISSUE(kt_) do { const bf16_t* kvrow_ = kvbase + (size_t)(kt_) * 128 * 512; kn[0] = *(const u32x4*)(kvrow_); kn[1] = *(const u32x4*)(kvrow_ + 64 * 512); \
        vn[0] = *(const u32x4*)(kvrow_ + 64); vn[1] = *(const u32x4*)(kvrow_ + 64 * 512 + 64); kr8 = *(const u32x4*)(krbase + (size_t)(kt_) * 128 * 32); } while (0)
    ATT_ISSUE(0);
    bf16x8 qf[3];
    { const bf16_t* qrow = C.qb() + rq * 512 + h * 96;
#pragma unroll
      for (int kk = 0; kk < 3; ++kk) { const u32x4 raw = *(const u32x4*)(qrow + kk * 32 + fq * 8); float x[8] = {bflo(raw.x), bfhi(raw.x), bflo(raw.y), bfhi(raw.y), bflo(raw.z), bfhi(raw.z), bflo(raw.w), bfhi(raw.w)};
          if (kk == 2 && !ctx) {
#pragma unroll
              for (int e = 0; e < 8; ++e) { const float partner = __shfl_xor(x[e], 16); const float rot = (fq & 1) ? partner : -partner; const int d = fq * 8 + e;
                  x[e] = x[e] * C.ropec()[tq * 32 + d] + rot * C.ropes()[tq * 32 + d]; } }
          u32x4 o; o.x = pk2(x[0] * SCL, x[1] * SCL); o.y = pk2(x[2] * SCL, x[3] * SCL); o.z = pk2(x[4] * SCL, x[5] * SCL); o.w = pk2(x[6] * SCL, x[7] * SCL);
          qf[kk] = __builtin_bit_cast(bf16x8, o); } }
    float m_run = -1e30f, l_run = 0.f; f32x4 o[4];
#pragma unroll
    for (int pt = 0; pt < 4; ++pt) o[pt] = (f32x4){0.f, 0.f, 0.f, 0.f};
    __syncthreads();
    for (int kt = 0; kt < nkt; ++kt) {
        LAS bf16_t* sK = (LAS bf16_t*)(lds + (kt & 1) * AT_BUF + AT_K); LAS bf16_t* sVT = (LAS bf16_t*)(lds + (kt & 1) * AT_BUF + AT_VT);
        if (MODE != 2) { *(LAS u32x4*)(sK + rj * 104 + 64 + rp * 8) = kr8;
#pragma unroll
          for (int ps = 0; ps < 2; ++ps) { const int j = lj + 64 * ps, jsw = j ^ (8 * p8); *(LAS u32x4*)(sK + j * 104 + p8 * 8) = kn[ps];
              const unsigned va[4] = {vn[ps].x, vn[ps].y, vn[ps].z, vn[ps].w};
#pragma unroll
              for (int e = 0; e < 4; ++e) { sVT[(p8 * 8 + 2 * e) * 136 + jsw] = (bf16_t)(va[e] & 0xffffu); sVT[(p8 * 8 + 2 * e + 1) * 136 + jsw] = (bf16_t)(va[e] >> 16); } } }
        if (MODE != 2 && kt + 1 < nkt) ATT_ISSUE(kt + 1);
        LDS_BARRIER();
        if (MODE == 1) continue;
        f32x4 s[8]; float mx = -1e30f;
        {
            bf16x8 kf[8][3];
#pragma unroll
            for (int jt = 0; jt < 8; ++jt)
#pragma unroll
                for (int kk = 0; kk < 3; ++kk) kf[jt][kk] = *(const LAS bf16x8*)(sK + (16 * jt + fr) * 104 + kk * 32 + fq * 8);
            SCHED_FENCE();
#pragma unroll
            for (int jt = 0; jt < 8; ++jt) s[jt] = MFMA16(kf[jt][0], qf[0], ((f32x4){0.f, 0.f, 0.f, 0.f}));
#pragma unroll
            for (int kk = 1; kk < 3; ++kk)
#pragma unroll
                for (int jt = 0; jt < 8; ++jt) s[jt] = MFMA16(kf[jt][kk], qf[kk], s[jt]);
            SCHED_FENCE();
        }
        u32x2 va[4][4], vb[4][4];
#pragma unroll
        for (int kk = 0; kk < 4; ++kk)
#pragma unroll
            for (int pt = 0; pt < 4; ++pt) { const LAS bf16_t* vr = sVT + (16 * pt + fr) * 136; const int sw = 8 * ((2 * pt + (fr >> 3)) & 7); va[kk][pt] = *(const LAS u32x2*)(vr + ((32 * kk + 4 * fq) ^ sw)); vb[kk][pt] = *(const LAS u32x2*)(vr + ((32 * kk + 16 + 4 * fq) ^ sw)); }
        SCHED_FENCE();
#pragma unroll
        for (int jt = 0; jt < 8; ++jt) mx = fmaxf(mx, fmaxf(fmaxf(s[jt][0], s[jt][1]), fmaxf(s[jt][2], s[jt][3])));
        mx = fmaxf(mx, __shfl_xor(mx, 16)); mx = fmaxf(mx, __shfl_xor(mx, 32));
        const float m_new = fmaxf(m_run, mx), alpha = __builtin_amdgcn_exp2f(m_run - m_new); m_run = m_new;
        float ls = 0.f;
#pragma unroll
        for (int jt = 0; jt < 8; ++jt)
#pragma unroll
            for (int e = 0; e < 4; ++e) { s[jt][e] = __builtin_amdgcn_exp2f(s[jt][e] - m_new); ls += s[jt][e]; }
        l_run = l_run * alpha + ls;
#pragma unroll
        for (int pt = 0; pt < 4; ++pt) o[pt] = o[pt] * alpha;
        bf16x8 yp[4];
#pragma unroll
        for (int kk = 0; kk < 4; ++kk) { u32x4 yw; yw.x = pk2(s[2 * kk][0], s[2 * kk][1]); yw.y = pk2(s[2 * kk][2], s[2 * kk][3]); yw.z = pk2(s[2 * kk + 1][0], s[2 * kk + 1][1]); yw.w = pk2(s[2 * kk + 1][2], s[2 * kk + 1][3]);
            yp[kk] = __builtin_bit_cast(bf16x8, yw); }
        SCHED_FENCE();
#pragma unroll
        for (int kk = 0; kk < 4; ++kk)
#pragma unroll
            for (int pt = 0; pt < 4; ++pt) { const u32x4 xw = (u32x4){va[kk][pt].x, va[kk][pt].y, vb[kk][pt].x, vb[kk][pt].y}; o[pt] = MFMA16(__builtin_bit_cast(bf16x8, xw), yp[kk], o[pt]); }
        SCHED_FENCE();
    }
#undef ATT_ISSUE
    float l = l_run + __shfl_xor(l_run, 16); l += __shfl_xor(l, 32); const float inv = 1.0f / l;
    if (MODE != 0 && l != 12345.678f) return;
    bf16_t* orow = C.abuf() + rq * 1024 + 768 + h * 64;
#pragma unroll
    for (int pt = 0; pt < 4; ++pt) { u32x2 w; w.x = pk2(o[pt][0] * inv, o[pt][1] * inv); w.y = pk2(o[pt][2] * inv, o[pt][3] * inv); *(u32x2*)(orow + 16 * pt + 4 * fq) = w; }
}

__device__ __forceinline__ int mix_unit_of(int bid, int G, int k) {
    if (G != 256) { const int idx = bid + k * G; return idx < 1472 ? idx : -1; }
    if (k == 0) return bid;
    if (bid < 192) {
        if (k == 1) return 256 + bid;
        if (k == 2 || k == 3) return 448 + 384 + 2 * bid + (k - 2);
        if (k == 4) return 448 + 768 + 64 + bid;
        return -1; }
    const int j = bid - 192;
    if (k <= 6) return 448 + 6 * j + (k - 1);
    if (k == 7) return 448 + 768 + j;
    return -1;
}
__device__ __forceinline__ void phase_mixers(Ctx& C, int layer) {
    for (int k = 0;; ++k) {
        int idx = mix_unit_of(C.bid, C.G, k); if (idx < 0) break;
        if (idx < 256) { const int rest = idx >> 3; attn_unit<0>(C, false, idx & 7, rest >> 3, rest & 7); continue; }
        idx -= 256;
        if (idx < 192) { const int b = idx & 7, rem = idx >> 3;
            if (rem < 16) scan_unit(C, layer, 0, false, b, rem >> 1, rem & 1); else scan_unit(C, layer, 1, false, b, (rem - 16) >> 1, rem & 1);
            continue; }
        idx -= 192;
        if (idx < 512) { scan_unit(C, layer, 0, true, idx >> 4, (idx >> 1) & 7, idx & 1); continue; }
        idx -= 512;
        if (idx < 256) { scan_unit(C, layer, 1, true, idx >> 3, (idx >> 1) & 3, idx & 1); continue; }
        idx -= 256;
        attn_unit<0>(C, true, idx >> 3, (idx >> 1) & 3, idx & 1);
    }
}

__device__ __forceinline__ void phase_mix(Ctx& C, int layer) {
    TIDS;
    const int gw = C.bid * NWAVES + wave, NGW = C.G * NWAVES;
    const float Dh = C.in(16)[layer * 8 + (lane >> 3)];
    const f32x4 nw0 = *(const f32x4*)(C.in(17) + layer * 512 + 8 * lane), nw1 = *(const f32x4*)(C.in(17) + layer * 512 + 8 * lane + 4);
    const f32x4 gw4 = *(const f32x4*)(C.in(19) + layer * 256 + 4 * lane);
    for (int r0 = gw; r0 < NTOK; r0 += 2 * NGW) {
        u32x4 yf[2], yb[2], xs[2], z[2]; u32x2 of[2], ob[2], g[2]; int rr[2];
#pragma unroll
        for (int q = 0; q < 2; ++q) { const int r = xcd_row(r0 + q * NGW < NTOK ? r0 + q * NGW : r0, C.G); rr[q] = r; const bf16_t* ur = C.ub() + (size_t)r * UP;
            yf[q] = *(const u32x4*)(C.yssd() + (size_t)r * 512 + 8 * lane); yb[q] = *(const u32x4*)(C.yssd() + (size_t)(NTOK + r) * 512 + 8 * lane);
            xs[q] = *(const u32x4*)(C.xbc() + (size_t)r * 768 + 8 * lane); z[q] = *(const u32x4*)(ur + 8 * lane);
            of[q] = *(const u32x2*)(C.yret() + (size_t)r * 256 + 4 * lane); ob[q] = *(const u32x2*)(C.yret() + (size_t)(NTOK + r) * 256 + 4 * lane); g[q] = *(const u32x2*)(ur + U_RG + 4 * lane); }
#pragma unroll
        for (int q = 0; q < 2; ++q) { const int r = rr[q];
          { const unsigned yfa[4] = {yf[q].x, yf[q].y, yf[q].z, yf[q].w}, yba[4] = {yb[q].x, yb[q].y, yb[q].z, yb[q].w}, xsa[4] = {xs[q].x, xs[q].y, xs[q].z, xs[q].w}, za[4] = {z[q].x, z[q].y, z[q].z, z[q].w};
            float v[8]; float ss = 0.f;
#pragma unroll
            for (int e = 0; e < 4; ++e) { v[2 * e] = (bflo(yfa[e]) + bflo(yba[e]) + Dh * bflo(xsa[e])) * pg8::silu_f(bflo(za[e])); v[2 * e + 1] = (bfhi(yfa[e]) + bfhi(yba[e]) + Dh * bfhi(xsa[e])) * pg8::silu_f(bfhi(za[e]));
                ss += v[2 * e] * v[2 * e] + v[2 * e + 1] * v[2 * e + 1]; }
            const float rstd = rsqrtf(wave_sum(ss) * (1.f / 512) + EPS);
            u32x4 o; o.x = pk2(v[0] * rstd * nw0.x, v[1] * rstd * nw0.y); o.y = pk2(v[2] * rstd * nw0.z, v[3] * rstd * nw0.w); o.z = pk2(v[4] * rstd * nw1.x, v[5] * rstd * nw1.y); o.w = pk2(v[6] * rstd * nw1.z, v[7] * rstd * nw1.w);
            *(u32x4*)(C.abuf() + (size_t)r * 1024 + 8 * lane) = o; }
          { const float o0 = bflo(of[q].x) + bflo(ob[q].x), o1 = bfhi(of[q].x) + bfhi(ob[q].x), o2 = bflo(of[q].y) + bflo(ob[q].y), o3 = bfhi(of[q].y) + bfhi(ob[q].y);
            const float s4 = row16_sum((o0 + o1) + (o2 + o3));
            const float mu = s4 * (1.f / 64); const float d0 = o0 - mu, d1 = o1 - mu, d2 = o2 - mu, d3 = o3 - mu; const float vq = row16_sum((d0 * d0 + d1 * d1) + (d2 * d2 + d3 * d3));
            const float rs = rsqrtf(vq * (1.f / 64) + EPS);
            u32x2 o; o.x = pk2(d0 * rs * gw4.x * pg8::silu_f(bflo(g[q].x)), d1 * rs * gw4.y * pg8::silu_f(bfhi(g[q].x))); o.y = pk2(d2 * rs * gw4.z * pg8::silu_f(bflo(g[q].y)), d3 * rs * gw4.w * pg8::silu_f(bfhi(g[q].y)));
            *(u32x2*)(C.abuf() + (size_t)r * 1024 + 512 + 4 * lane) = o; }
        }
    }
}

#define XB_TMO      128
#define XB_XCNT(j)  (256  + 64 * (j))
#define XB_XSUB(j)  (1280 + 64 * (j))
#define XB_XGEN(j)  (2304 + 64 * (j))
#define XB_TOP      3328
#define XB_TOPGEN   3392
#define XCD_BAR_WORDS 3456
#define XB_SPIN_CAP (1u << 18)
__device__ __forceinline__ unsigned xb_ld(unsigned* p)              { return __hip_atomic_load(p, __ATOMIC_RELAXED, __HIP_MEMORY_SCOPE_AGENT); }
__device__ __forceinline__ unsigned xb_add(unsigned* p, unsigned v) { return __hip_atomic_fetch_add(p, v, __ATOMIC_RELAXED, __HIP_MEMORY_SCOPE_AGENT); }
__device__ __forceinline__ unsigned xb_xcc_id() { return (unsigned)__builtin_amdgcn_s_getreg((3 << 11) | 20) & 0xFu; }
#define XB_SPIN(cond, bar) do { unsigned _sp = 0; while (cond) { __builtin_amdgcn_s_sleep(1); \
    if ((++_sp & 255u) == 0u) { if (xb_ld(&(bar)[XB_TMO])) break; if (_sp > XB_SPIN_CAP) { atomicAdd(&(bar)[XB_TMO], 1u); break; } } } } while (0)
struct XcdBarrier { unsigned* bar; unsigned x; volatile LAS unsigned* st; };
__device__ __forceinline__ XcdBarrier xcd_barrier_post(unsigned* bar, volatile LAS unsigned* st) {
    XcdBarrier b; b.bar = bar; b.x = xb_xcc_id(); b.st = st;
    if (threadIdx.x == 0) (void)xb_add(&bar[XB_XCNT(b.x)], 1u);
    return b;
}
__device__ __forceinline__ void xcd_barrier_complete(unsigned* bar, unsigned x, unsigned& nloc, unsigned& nx) {
    const unsigned G = gridDim.x * gridDim.y * gridDim.z;
    unsigned sum, cnt, mine, sp = 0u;
    for (;;) {
        sum = 0u; cnt = 0u; mine = 0u;
#pragma unroll
        for (unsigned j = 0; j < 16; ++j) { const unsigned c = xb_ld(&bar[XB_XCNT(j)]); sum += c; cnt += (c > 0u) ? 1u : 0u; mine = (j == x) ? c : mine; }
        if (sum == G) break;
        __builtin_amdgcn_s_sleep(1);
        if ((++sp & 255u) == 0u) { if (xb_ld(&bar[XB_TMO])) break; if (sp > XB_SPIN_CAP) { atomicAdd(&bar[XB_TMO], 1u); break; } }
    }
    nloc = mine > 0u ? mine : 1u; nx = cnt > 0u ? cnt : 1u;
}
__device__ __forceinline__ void xcd_barrier(const XcdBarrier& b) {
    asm volatile("s_waitcnt vmcnt(0)" ::: "memory");
    __syncthreads();
    if (threadIdx.x == 0) {
        unsigned* bar = b.bar;
        __builtin_amdgcn_s_waitcnt(0);
        unsigned nloc = b.st[0], nx = b.st[1];
        if (nloc == 0u) { xcd_barrier_complete(bar, b.x, nloc, nx); b.st[0] = nloc; b.st[1] = nx; }
        const unsigned old = xb_add(&bar[XB_XSUB(b.x)], 1u);
        const unsigned gen = old / nloc;
        if (old + 1u == (gen + 1u) * nloc) {
            __builtin_amdgcn_fence(__ATOMIC_RELEASE, "agent");
            asm volatile("s_waitcnt vmcnt(0)" ::: "memory");
            const unsigned og = xb_add(&bar[XB_TOP], 1u);
            const unsigned tg = og / nx;
            if (og + 1u == (tg + 1u) * nx) xb_add(&bar[XB_TOPGEN], 1u);
            else XB_SPIN(xb_ld(&bar[XB_TOPGEN]) == tg, bar);
            __builtin_amdgcn_fence(__ATOMIC_ACQUIRE, "agent");
            xb_add(&bar[XB_XGEN(b.x)], 1u);
            asm volatile("s_waitcnt vmcnt(0)" ::: "memory");
        } else {
            XB_SPIN(xb_ld(&bar[XB_XGEN(b.x)]) == gen, bar);
            __builtin_amdgcn_fence(__ATOMIC_ACQUIRE, "agent");
            asm volatile("s_waitcnt vmcnt(0)" ::: "memory");
        }
    }
    __syncthreads();
}
constexpr int MISC_OFF = 141312;
constexpr size_t WS_BAR = 65536;

constexpr int NSUB = 9, NPHASE = 2 + NSUB * DEPTH;

__global__ void __launch_bounds__(NTHR) mk_fwd(Args args) {
    extern __shared__ __attribute__((aligned(16))) unsigned char lds_raw[];
    {
        LAS unsigned long long* ptab = (LAS unsigned long long*)((LAS unsigned char*)lds_raw + PT_OFF);
        if (threadIdx.x < 29) ptab[threadIdx.x] = (unsigned long long)args.in[threadIdx.x];
        if (threadIdx.x < 32) ((LAS unsigned*)((LAS unsigned char*)lds_raw + MISC_OFF))[threadIdx.x] = 0u;
        __syncthreads();
    }
    XcdBarrier xbar; xbar.bar = (unsigned*)(args.ws + WS_BAR); xbar.x = 0; xbar.st = nullptr;
    if (MK_SINGLE) xbar = xcd_barrier_post((unsigned*)(args.ws + WS_BAR), (volatile LAS unsigned*)((LAS unsigned char*)lds_raw + MISC_OFF) + 8);
    cg::grid_group grid = cg::this_grid();
    int probe_rep = 0;
    for (int ph = args.ph_lo; ph < args.ph_hi; ++ph) {
        Ctx C; C.lds = (LAS unsigned char*)lds_raw; C.G = gridDim.x; C.bid = blockIdx.x;
        { GAS unsigned char* ws_ = (GAS unsigned char*)args.ws; GAS float* out_ = (GAS float*)args.out; asm volatile("" : "+s"(ws_), "+s"(out_)); C.ws = (unsigned char*)ws_; C.out = (float*)out_; }
        if (ph == 0) phase_prologue(C);
        else if (ph == NPHASE - 1) phase_norm_b<1>(C, C.in(28), nullptr, 0, 0);
        else {
            const int layer = (ph - 1) / NSUB, sub = (ph - 1) % NSUB;
            const float* modl = C.mod() + (size_t)layer * 9 * 6144; bf16_t* wl = C.wts() + (size_t)layer * WL_TOTAL;
            switch (sub) {
            case 0: if (layer == 0) phase_norm<0>(C, C.in(0), C.in(1), C.in(10), modl, 0, 1024); else phase_norm_b<0>(C, C.in(10) + layer * DM, modl, 0, 1024); break;
            case 1: { pg8::Gemm g{C.abuf(), wl + WL_IN, NTOK, UP, DM}; pg8::StaticOrder S; S.init(NTOK, UP, C.G, C.bid); pg8::EpiBf16 E{C.ub(), UP};
                      pg8::gemm_phase<pg8::EpiBf16, pg8::StaticOrder, true, true>(C.lds, g, S, E);
                      if (layer == 0) {
                          const int rem = S.nwg % C.G; const bool all = rem == 0;
                          if (all || C.bid >= rem) { TIDS; (void)tid; __syncthreads(); convert_weights(C, 0, ((all ? C.bid : C.bid - rem)) * NWAVES + wave, (all ? C.G : C.G - rem) * NWAVES, wave, lane, 2); }
                      } } break;
            case 2: phase_prep(C, layer); break;
            case 3: phase_mixers(C, layer); break;
            case 4: phase_mix(C, layer); break;
            case 5: { pg8::Gemm g{C.abuf(), wl + WL_OUT, NTOK, DM, DM}; pg8::StaticOrder S; S.init(NTOK, DM, C.G, C.bid); pg8::EpiRes E{layer == 0 ? C.in(0) : nullptr, layer == 0 ? C.in(1) : nullptr, C.xb(), modl + 2048};
                      pg8::gemm_phase<pg8::EpiRes, pg8::StaticOrder, false, true>(C.lds, g, S, E); } break;
            case 6: phase_norm_b<0>(C, C.in(25) + layer * DM, modl, 3072, 4096); break;
            case 7: { pg8::Gemm g{C.abuf(), wl + WL_W1, NTOK, 2 * DFF, DM}; pg8::StaticOrder S; S.init(NTOK, 2 * DFF, C.G, C.bid); pg8::EpiSwiGLU E{C.ub(), DFF};
                      pg8::gemm_phase<pg8::EpiSwiGLU, pg8::StaticOrder, true, true>(C.lds, g, S, E);
                      if (layer + 1 < DEPTH) {
                          const int rem = S.nwg % C.G; const bool all = rem == 0;
                          if (all || C.bid >= rem) { TIDS; (void)tid; __syncthreads(); if (layer == 0) convert_weights(C, 0, ((all ? C.bid : C.bid - rem)) * NWAVES + wave, (all ? C.G : C.G - rem) * NWAVES, wave, lane, 3); convert_weights(C, layer + 1, ((all ? C.bid : C.bid - rem)) * NWAVES + wave, (all ? C.G : C.G - rem) * NWAVES, wave, lane); }
                      } } break;
            case 8: { pg8::Gemm g{C.ub(), wl + WL_W2, NTOK, DM, DFF}; pg8::StaticOrder S; S.init(NTOK, DM, C.G, C.bid); pg8::EpiRes E{nullptr, nullptr, C.xb(), modl + 5120};
                      pg8::gemm_phase<pg8::EpiRes, pg8::StaticOrder, false, true>(C.lds, g, S, E); } break;
            }
        }
        if (ph + 1 < args.ph_hi) { if (args.ph_hi > 1000) grid.sync(); else xcd_barrier(xbar); }
        if (PROBE_SUB >= 0) { if (((ph > 0 && ph < NPHASE - 1 && (ph - 1) % NSUB == PROBE_SUB) || (PROBE_SUB == 100 && ph == 0)) && probe_rep == 0) { probe_rep = 1; --ph; } else probe_rep = 0; }
    }
}

extern "C" void kernel_launch(void* const* d_in, const int* in_sizes, int n_in, void* d_out, int out_size, void* d_ws, size_t ws_size, hipStream_t stream) {
    static int grid = 0;
    if (grid == 0) {
        if (n_in != 29 || ws_size < WS_END) { fprintf(stderr, "kernel_launch: unexpected inputs (n_in %d) or workspace %zu < %zu\n", n_in, ws_size, (size_t)WS_END); grid = -1; return; }
        int dev = 0, cus = 0, per_cu = 0;
        hipGetDevice(&dev); hipDeviceGetAttribute(&cus, hipDeviceAttributeMultiprocessorCount, dev);
        hipFuncSetAttribute((const void*)mk_fwd, hipFuncAttributeMaxDynamicSharedMemorySize, LDS_BYTES);
        hipOccupancyMaxActiveBlocksPerMultiprocessor(&per_cu, (const void*)mk_fwd, NTHR, LDS_BYTES);
        if (per_cu < 1) { fprintf(stderr, "kernel_launch: occupancy query says %d blocks per CU\n", per_cu); per_cu = 1; }
        (void)hipGetLastError();
        grid = cus * 1;
    }
    if (grid < 0) return;
    Args a{};
    for (int i = 0; i < 29; ++i) a.in[i] = (const float*)d_in[i];
    a.out = (float*)d_out; a.ws = (unsigned char*)d_ws;
#if MK_SINGLE
    if (hipMemsetAsync(d_ws, 0, 1u << 20, stream) != hipSuccess) { fprintf(stderr, "kernel_launch: memset failed\n"); return; }
    a.ph_lo = 0; a.ph_hi = NPHASE;
    void* kargs[] = {&a};
    hipError_t e = hipLaunchCooperativeKernel((const void*)mk_fwd, dim3(grid), dim3(NTHR), kargs, LDS_BYTES, stream);
    if (e != hipSuccess) fprintf(stderr, "cooperative launch failed: %s (grid %d)\n", hipGetErrorString(e), grid);
#else
    for (int ph = 0; ph < NPHASE; ++ph) { a.ph_lo = ph; a.ph_hi = ph + 1; hipLaunchKernelGGL(mk_fwd, dim3(grid), dim3(NTHR), LDS_BYTES, stream, a); }
#endif
}
```

```cpp
#include <hip/hip_runtime.h>
#include <hip/hip_cooperative_groups.h>
#include <cstdio>
#include <cstdint>
namespace cg = cooperative_groups;

#ifndef MK_SINGLE
#define MK_SINGLE 1
#endif

#ifndef PROBE_MIX
#define PROBE_MIX 0
#endif
#ifndef PROBE_NOX
#define PROBE_NOX 0
#endif
#ifndef PROBE_SUB
#define PROBE_SUB -1
#endif
#define LAS __attribute__((address_space(3)))
#define GAS __attribute__((address_space(1)))
typedef unsigned short bf16_t;
typedef short bf16x8 __attribute__((ext_vector_type(8)));
typedef float f32x4 __attribute__((ext_vector_type(4)));
typedef float f32x2 __attribute__((ext_vector_type(2)));
typedef unsigned u32x4 __attribute__((ext_vector_type(4)));
typedef unsigned u32x2 __attribute__((ext_vector_type(2)));

namespace pg8 {
constexpr int BM = 256, BK = 64, HALF = 128, HTB = HALF * BK * 2, STAGE_BYTES = 8 * HTB, NXCD = 8, WGM = 8;
__host__ __device__ __forceinline__ int lds_byte(int r, int c) { const int st = (r >> 4) * 2 + (c >> 5), rr = r & 15, cc = c & 31, ob = rr * 64 + cc * 2; return st * 1024 + (ob ^ (((ob >> 9) & 1) << 5)); }
__host__ __device__ __forceinline__ void stage_rc(int b, int& R, int& C) { const int st = b / 1024, sb = b % 1024, swz = sb ^ (((sb >> 9) & 1) << 5); R = (st >> 1) * 16 + swz / 64; C = (st & 1) * 32 + (swz % 64) / 2; }
__host__ __device__ __forceinline__ int perm32(int rho) { const int n = rho >> 4, i = rho & 15; return 8 * (i >> 2) + 4 * n + (i & 3); }

struct Unit { int pm, pn; };
struct Gemm { const bf16_t* A; const bf16_t* Bt; int M, N, K; };

struct StaticOrder {
    int nM, nN, nwg, G, c;
    __host__ __device__ void init(int M, int N, int G_, int c_) { nM = M / BM; nN = N / BM; nwg = nM * nN; G = G_; c = c_; }
    __host__ __device__ bool next(int i, Unit& u) const {
        const long L = (long)i * G + c; if (L >= nwg) return false;
        int wgid = (int)L; { const int q = nwg / NXCD, r = nwg % NXCD, xcd = wgid % NXCD, off = wgid / NXCD; wgid = (xcd < r ? xcd * (q + 1) : r * (q + 1) + (xcd - r) * q) + off; }
        const int nig = WGM * nN, gid = wgid / nig, fm = gid * WGM, gsz = (nM - fm) < WGM ? (nM - fm) : WGM;
        u.pm = fm + ((wgid % nig) % gsz); u.pn = (wgid % nig) / gsz; return true;
    }
    __device__ __forceinline__ void a_ready(const Unit&) const {}
    __device__ __forceinline__ void done(const Unit&) const {}
};

__device__ __forceinline__ void st16_wt(void* p, u32x4 v) { asm volatile("global_store_dwordx4 %0, %1, off sc1" :: "v"(p), "v"(v) : "memory"); }
__device__ __forceinline__ unsigned cvt_pk_bf16(float lo, float hi) { unsigned r; asm volatile("v_cvt_pk_bf16_f32 %0, %1, %2" : "=v"(r) : "v"(lo), "v"(hi)); return r; }

struct EpiBf16 {
    static constexpr bool PERM = true, AFTER_DRAIN = false;
    bf16_t* O; int ldc;
    __device__ __forceinline__ void operator()(const f32x4 (&acc)[2][2][4][2], const Unit& u, int wr, int wc, int fr_, int fq_) const {
        int fr = fr_, fq = fq_; asm volatile("" : "+v"(fr), "+v"(fq));
        const int row0 = u.pm * BM + wr * 64 + fr; const int col0 = u.pn * BM + wc * 32 + 8 * fq;
#pragma unroll
        for (int ai = 0; ai < 2; ++ai)
#pragma unroll
            for (int m = 0; m < 4; ++m) { bf16_t* rowp = O + (size_t)(row0 + ai * HALF + m * 16) * ldc + col0;
#pragma unroll
                for (int bj = 0; bj < 2; ++bj) { const f32x4 v0 = acc[ai][bj][m][0], v1 = acc[ai][bj][m][1];
                    u32x4 w; w.x = cvt_pk_bf16(v0[0], v0[1]); w.y = cvt_pk_bf16(v0[2], v0[3]); w.z = cvt_pk_bf16(v1[0], v1[1]); w.w = cvt_pk_bf16(v1[2], v1[3]);
                    st16_wt(rowp + bj * HALF, w); } }
    }
};
__device__ __forceinline__ float silu_f(float a) { return a * __builtin_amdgcn_rcpf(1.0f + __builtin_amdgcn_exp2f(-1.4426950408889634f * a)); }
struct EpiSwiGLU {
    static constexpr bool PERM = true, AFTER_DRAIN = false;
    bf16_t* O; int ldc;
    __device__ __forceinline__ void operator()(const f32x4 (&acc)[2][2][4][2], const Unit& u, int wr, int wc, int fr_, int fq_) const {
        int fr = fr_, fq = fq_; asm volatile("" : "+v"(fr), "+v"(fq));
        const int row0 = u.pm * BM + wr * 64 + fr; const int col0 = u.pn * HALF + wc * 32 + 8 * fq;
#pragma unroll
        for (int ai = 0; ai < 2; ++ai)
#pragma unroll
            for (int m = 0; m < 4; ++m) { bf16_t* rowp = O + (size_t)(row0 + ai * HALF + m * 16) * ldc + col0;
                const f32x4 a0 = acc[ai][0][m][0], a1 = acc[ai][0][m][1], g0 = acc[ai][1][m][0], g1 = acc[ai][1][m][1];
                u32x4 w;
                w.x = cvt_pk_bf16(silu_f(a0[0]) * g0[0], silu_f(a0[1]) * g0[1]); w.y = cvt_pk_bf16(silu_f(a0[2]) * g0[2], silu_f(a0[3]) * g0[3]);
                w.z = cvt_pk_bf16(silu_f(a1[0]) * g1[0], silu_f(a1[1]) * g1[1]); w.w = cvt_pk_bf16(silu_f(a1[2]) * g1[2], silu_f(a1[3]) * g1[3]);
                st16_wt(rowp, w); }
    }
};
struct EpiRes {
    static constexpr bool PERM = true, AFTER_DRAIN = false;
    const float* xin_lo; const float* xin_hi;
    bf16_t* xb; const float* gate;
    __device__ __forceinline__ void operator()(const f32x4 (&acc)[2][2][4][2], const Unit& u, int wr, int wc, int fr_, int fq_) const {
        int fr = fr_, fq = fq_; asm volatile("" : "+v"(fr), "+v"(fq));
        const int rt = u.pm * BM; const int cond = rt < 8192 ? 0 : 1 + ((rt - 8192) >> 10);
        const int col0 = u.pn * BM + wc * 32 + 8 * fq; const float* g = gate + cond * 6144 + col0;
        bf16_t* dst = xb + (size_t)rt * 1024 + col0;
        f32x4 gv[2][2];
#pragma unroll
        for (int bj = 0; bj < 2; ++bj)
#pragma unroll
            for (int n = 0; n < 2; ++n) gv[bj][n] = *(const f32x4*)(g + bj * HALF + 4 * n);
        if (xin_lo != nullptr) {
            const float* src = (rt < 8192 ? xin_lo + (size_t)rt * 1024 : xin_hi + (size_t)(rt - 8192) * 1024) + col0;
#pragma unroll
            for (int am = 0; am < 8; ++am) {
                const int ai = am >> 2, m = am & 3; const size_t off = (size_t)(ai * HALF + wr * 64 + m * 16 + fr) * 1024;
                f32x4 xv[2][2];
#pragma unroll
                for (int bj = 0; bj < 2; ++bj)
#pragma unroll
                    for (int n = 0; n < 2; ++n) xv[bj][n] = *(const f32x4*)(src + off + bj * HALF + 4 * n);
#pragma unroll
                for (int bj = 0; bj < 2; ++bj) { const f32x4 v0 = xv[bj][0] + gv[bj][0] * acc[ai][bj][m][0], v1 = xv[bj][1] + gv[bj][1] * acc[ai][bj][m][1];
                    u32x4 w; w.x = cvt_pk_bf16(v0[0], v0[1]); w.y = cvt_pk_bf16(v0[2], v0[3]); w.z = cvt_pk_bf16(v1[0], v1[1]); w.w = cvt_pk_bf16(v1[2], v1[3]);
                    *(u32x4*)(dst + off + bj * HALF) = w; }
            }
        } else {
#pragma unroll
            for (int ai = 0; ai < 2; ++ai) {
                u32x4 xv[4][2];
#pragma unroll
                for (int m = 0; m < 4; ++m) { const size_t off = (size_t)(ai * HALF + wr * 64 + m * 16 + fr) * 1024;
#pragma unroll
                    for (int bj = 0; bj < 2; ++bj) xv[m][bj] = *(const u32x4*)(dst + off + bj * HALF); }
#pragma unroll
                for (int m = 0; m < 4; ++m) { const size_t off = (size_t)(ai * HALF + wr * 64 + m * 16 + fr) * 1024;
#pragma unroll
                    for (int bj = 0; bj < 2; ++bj) { const u32x4 x = xv[m][bj];
                        const f32x4 x0 = (f32x4){__uint_as_float(x.x << 16), __uint_as_float(x.x & 0xffff0000u), __uint_as_float(x.y << 16), __uint_as_float(x.y & 0xffff0000u)};
                        const f32x4 x1 = (f32x4){__uint_as_float(x.z << 16), __uint_as_float(x.z & 0xffff0000u), __uint_as_float(x.w << 16), __uint_as_float(x.w & 0xffff0000u)};
                        const f32x4 v0 = x0 + gv[bj][0] * acc[ai][bj][m][0], v1 = x1 + gv[bj][1] * acc[ai][bj][m][1];
                        u32x4 w; w.x = cvt_pk_bf16(v0[0], v0[1]); w.y = cvt_pk_bf16(v0[2], v0[3]); w.z = cvt_pk_bf16(v1[0], v1[1]); w.w = cvt_pk_bf16(v1[2], v1[3]);
                        *(u32x4*)(dst + off + bj * HALF) = w; } }
            }
        }
    }
};

template <class Epi, class Sched, bool ALIGN_EPI = false, bool SP2 = false>
__device__ __forceinline__ void gemm_phase(LAS unsigned char* lds, const Gemm g, const Sched& S, const Epi& E) {
    int tid_ = threadIdx.x; asm volatile("" : "+v"(tid_));
    const int tid = tid_, wid = __builtin_amdgcn_readfirstlane(tid >> 6), lane = tid & 63, wr = wid >> 2, wc = wid & 3, fr = lane & 15, fq = lane >> 4;
    const int K = g.K, nt = K / BK;
    unsigned voffA[2], voffB[2];
#pragma unroll
    for (int i = 0; i < 2; ++i) { int R, C; stage_rc(tid * 16 + i * 8192, R, C); const int Rb = Epi::PERM ? ((R & ~31) + perm32(R & 31)) : R;
        voffA[i] = (unsigned)(R * K + C) * 2u; voffB[i] = (unsigned)(Rb * K + C) * 2u; }
    const size_t kstep = (size_t)(BK * 2);
    const size_t hstep = (size_t)HALF * K * 2;
    const size_t tstep = 2 * hstep;
    const unsigned ldsw = (unsigned)wid * 1024u;
    const int aoff = lds_byte(wr * 64 + fr, fq * 8), boff = lds_byte(wc * 32 + fr, fq * 8);
#define PG8_SA(b, h) (((b) * 2 + (h)) * HTB)
#define PG8_SB(b, h) ((4 + (b) * 2 + (h)) * HTB)
#define PG8_STAGE(bufoff, gbase, voff) do { _Pragma("unroll") for (int _i = 0; _i < 2; ++_i) \
        __builtin_amdgcn_global_load_lds((const unsigned*)((const char*)(gbase) + (voff)[_i]), (LAS unsigned*)(lds + (bufoff) + ldsw + _i * 8192), 16, 0, 0); } while (0)
#define PG8_LDA(dst, b, h) do { _Pragma("unroll") for (int m = 0; m < 4; ++m) _Pragma("unroll") for (int k = 0; k < 2; ++k) dst[m][k] = *(const LAS bf16x8*)(lds + PG8_SA(b, h) + aoff + m * 2048 + k * 1024); } while (0)
#define PG8_LDB(dst, b, h) do { _Pragma("unroll") for (int n = 0; n < 2; ++n) _Pragma("unroll") for (int k = 0; k < 2; ++k) dst[n][k] = *(const LAS bf16x8*)(lds + PG8_SB(b, h) + boff + n * 2048 + k * 1024); } while (0)
#define PG8_MMA(ai, bj, At, Bt) do { __builtin_amdgcn_s_setprio(1); _Pragma("unroll") for (int m = 0; m < 4; ++m) _Pragma("unroll") for (int n = 0; n < 2; ++n) _Pragma("unroll") for (int k = 0; k < 2; ++k) \
        acc[ai][bj][m][n] = __builtin_amdgcn_mfma_f32_16x16x32_bf16(Bt[n][k], At[m][k], acc[ai][bj][m][n], 0, 0, 0); __builtin_amdgcn_s_setprio(0); } while (0)
#define PG8_WAIT_V(n) asm volatile("s_waitcnt vmcnt(" #n ")" ::: "memory")
#define PG8_WAIT_L(n) asm volatile("s_waitcnt lgkmcnt(" #n ")" ::: "memory")
#define PG8_BAR __builtin_amdgcn_s_barrier()
#define PG8_SCHED __builtin_amdgcn_sched_barrier(0)
    Unit cur, nxt; int ui = 0;
    if (!S.next(0, cur)) return;
    f32x4 acc[2][2][4][2];
#pragma unroll
    for (int a = 0; a < 2; ++a)
#pragma unroll
        for (int b = 0; b < 2; ++b)
#pragma unroll
            for (int m = 0; m < 4; ++m)
#pragma unroll
                for (int n = 0; n < 2; ++n) acc[a][b][m][n] = (f32x4){0.f, 0.f, 0.f, 0.f};
    bf16x8 At[4][2], B0[2][2], B1[2][2];
    const char* cA = (const char*)g.A + (size_t)cur.pm * tstep; const char* cB = (const char*)g.Bt + (size_t)cur.pn * tstep;
    S.a_ready(cur);
    if constexpr (SP2) {
        PG8_STAGE(PG8_SB(0, 0), cB, voffB); PG8_STAGE(PG8_SB(0, 1), cB + hstep, voffB); PG8_STAGE(PG8_SA(0, 0), cA, voffA); PG8_STAGE(PG8_SA(0, 1), cA + hstep, voffA);
        if (wr == 1) PG8_BAR;
        PG8_WAIT_V(2); PG8_BAR;
        PG8_STAGE(PG8_SB(1, 0), cB + kstep, voffB); PG8_STAGE(PG8_SA(1, 0), cA + kstep, voffA); PG8_STAGE(PG8_SB(1, 1), cB + hstep + kstep, voffB);
        PG8_WAIT_V(6); PG8_BAR;
    } else {
        PG8_STAGE(PG8_SB(0, 0), cB, voffB); PG8_STAGE(PG8_SA(0, 0), cA, voffA); PG8_STAGE(PG8_SB(0, 1), cB + hstep, voffB); PG8_STAGE(PG8_SA(0, 1), cA + hstep, voffA);
        if (wr == 1) PG8_BAR;
        PG8_WAIT_V(4); PG8_BAR;
        PG8_STAGE(PG8_SB(1, 0), cB + kstep, voffB); PG8_STAGE(PG8_SA(1, 0), cA + kstep, voffA); PG8_STAGE(PG8_SB(1, 1), cB + hstep + kstep, voffB);
        PG8_WAIT_V(6); PG8_BAR;
    }
    for (;;) {
        const bool has_next = S.next(ui + 1, nxt);
        const char* nA = has_next ? (const char*)g.A + (size_t)nxt.pm * tstep : cA; const char* nB = has_next ? (const char*)g.Bt + (size_t)nxt.pn * tstep : cB;
        for (int t = 0; t < nt; t += 2) {
            const bool last = (t == nt - 2);
            const char* a1 = cA + (size_t)(t + 1) * kstep;
            const char* a2 = last ? nA : cA + (size_t)(t + 2) * kstep; const char* b2 = last ? nB : cB + (size_t)(t + 2) * kstep;
            const char* a3 = a2 + kstep; const char* b3 = b2 + kstep;
            if (last && has_next) S.a_ready(nxt);
            if constexpr (SP2) {
            PG8_LDB(B0, 0, 0); PG8_LDB(B1, 0, 1); PG8_SCHED; PG8_LDA(At, 0, 0); PG8_STAGE(PG8_SA(1, 1), a1 + hstep, voffA);
            PG8_WAIT_V(8); PG8_WAIT_L(0); PG8_BAR; PG8_MMA(0, 0, At, B0); PG8_MMA(0, 1, At, B1); PG8_BAR; PG8_SCHED;
            PG8_LDA(At, 0, 1); PG8_STAGE(PG8_SB(0, 0), b2, voffB); PG8_STAGE(PG8_SB(0, 1), b2 + hstep, voffB); PG8_STAGE(PG8_SA(0, 0), a2, voffA);
            PG8_WAIT_V(8); PG8_WAIT_L(0); PG8_BAR; PG8_MMA(1, 0, At, B0); PG8_MMA(1, 1, At, B1); PG8_BAR; PG8_SCHED;
            PG8_LDB(B0, 1, 0); PG8_LDB(B1, 1, 1); PG8_SCHED; PG8_LDA(At, 1, 0); PG8_STAGE(PG8_SA(0, 1), a2 + hstep, voffA);
            PG8_WAIT_V(8); PG8_WAIT_L(0); PG8_BAR; PG8_MMA(0, 0, At, B0); PG8_MMA(0, 1, At, B1); PG8_BAR; PG8_SCHED;
            PG8_LDA(At, 1, 1); PG8_STAGE(PG8_SB(1, 0), b3, voffB); PG8_STAGE(PG8_SB(1, 1), b3 + hstep, voffB); PG8_STAGE(PG8_SA(1, 0), a3, voffA);
            PG8_WAIT_V(8); PG8_WAIT_L(0); PG8_BAR; PG8_MMA(1, 0, At, B0); PG8_MMA(1, 1, At, B1); PG8_BAR; PG8_SCHED;
            } else {
            PG8_LDB(B0, 0, 0); PG8_SCHED; PG8_LDA(At, 0, 0); PG8_STAGE(PG8_SA(1, 1), a1 + hstep, voffA);
            PG8_WAIT_L(8); PG8_BAR; PG8_WAIT_L(0); PG8_MMA(0, 0, At, B0); PG8_BAR; PG8_SCHED;
            PG8_LDB(B1, 0, 1); PG8_STAGE(PG8_SB(0, 0), b2, voffB);
            PG8_BAR; PG8_WAIT_L(0); PG8_MMA(0, 1, At, B1); PG8_BAR;
            PG8_LDA(At, 0, 1); PG8_STAGE(PG8_SA(0, 0), a2, voffA);
            PG8_BAR; PG8_WAIT_L(0); PG8_MMA(1, 0, At, B0); PG8_BAR; PG8_SCHED;
            PG8_STAGE(PG8_SB(0, 1), b2 + hstep, voffB);
            PG8_WAIT_V(6); PG8_BAR; PG8_MMA(1, 1, At, B1); PG8_BAR;
            PG8_LDB(B0, 1, 0); PG8_SCHED; PG8_LDA(At, 1, 0); PG8_STAGE(PG8_SA(0, 1), a2 + hstep, voffA);
            PG8_WAIT_L(8); PG8_BAR; PG8_WAIT_L(0); PG8_MMA(0, 0, At, B0); PG8_BAR; PG8_SCHED;
            PG8_LDB(B1, 1, 1); PG8_STAGE(PG8_SB(1, 0), b3, voffB);
            PG8_BAR; PG8_WAIT_L(0); PG8_MMA(0, 1, At, B1); PG8_BAR;
            PG8_LDA(At, 1, 1); PG8_STAGE(PG8_SA(1, 0), a3, voffA);
            PG8_BAR; PG8_WAIT_L(0); PG8_MMA(1, 0, At, B0); PG8_BAR; PG8_SCHED;
            PG8_STAGE(PG8_SB(1, 1), b3 + hstep, voffB);
            PG8_WAIT_V(6); PG8_BAR; PG8_MMA(1, 1, At, B1); PG8_BAR;
            }
        }
        if constexpr (ALIGN_EPI) { if (wr == 0) PG8_BAR; }
        if constexpr (!Epi::AFTER_DRAIN) { E(acc, cur, wr, wc, fr, fq); S.done(cur); }
        if (!has_next) break;
#pragma unroll
        for (int a = 0; a < 2; ++a)
#pragma unroll
            for (int b = 0; b < 2; ++b)
#pragma unroll
                for (int m = 0; m < 4; ++m)
#pragma unroll
                    for (int n = 0; n < 2; ++n) acc[a][b][m][n] = (f32x4){0.f, 0.f, 0.f, 0.f};
        cur = nxt; cA = nA; cB = nB; ++ui;
        if constexpr (ALIGN_EPI) { if (wr == 1) PG8_BAR; }
    }
    PG8_WAIT_V(0);
    if constexpr (!ALIGN_EPI) { if (wr == 0) PG8_BAR; }
    PG8_BAR;
#undef PG8_SA
#undef PG8_SB
#undef PG8_STAGE
#undef PG8_LDA
#undef PG8_LDB
#undef PG8_MMA
#undef PG8_WAIT_V
#undef PG8_WAIT_L
#undef PG8_BAR
#undef PG8_SCHED
}
}

constexpr int NWAVES = 8, NTHR = 512;
constexpr int DM = 1024, NTOK = 16384, NCTXR = 8192, DEPTH = 4;
constexpr int UP = 2816;
constexpr int DFF = 2816;
constexpr int U_XBC = 512, U_DT = 1280, U_RQ = 1296, U_RK = 1552, U_RV = 1808, U_RG = 2064, U_MQ = 2320, U_MKV = 2576, U_MKR = 2704;
constexpr int KVROWS = 8192 + 8 * 1536;
constexpr float EPS = 1e-6f;
constexpr int LDS_BYTES = 147456;

constexpr size_t MiB = 1u << 20;
constexpr size_t WS_MOD = 1 * MiB, WS_ROPE = 2 * MiB, WS_DT = 3 * MiB, WS_LA = 4 * MiB, WS_KR = 5 * MiB, WS_CKV = 7 * MiB, WS_QC = 12 * MiB,
                 WS_Q = 20 * MiB, WS_KV = 36 * MiB, WS_XBC = 56 * MiB, WS_YSSD = 80 * MiB, WS_YRET = 112 * MiB, WS_ABUF = 128 * MiB, WS_U = 160 * MiB, WS_W = 248 * MiB;
constexpr size_t WL_IN = 0, WL_OUT = WL_IN + (size_t)UP * 1024, WL_W1 = WL_OUT + 1024 * 1024, WL_W2 = WL_W1 + (size_t)5632 * 1024, WL_UQ = WL_W2 + (size_t)1024 * 2816,
                 WL_UKV = WL_UQ + 512 * 256, WL_TOTAL = WL_UKV + 512 * 128;
constexpr size_t WS_XB = 348 * MiB;
constexpr size_t WS_END = 380 * MiB;
static_assert(WS_W + 4 * WL_TOTAL * 2 <= WS_XB, "d_ws map");

constexpr size_t O_YP = 0, O_YS = 8388608, O_SSD = 16777216, O_RET = 25165824, O_CKV = 29360128, O_KR = 33554432;

struct Args { const float* in[29]; float* out; unsigned char* ws; int ph_lo, ph_hi; };

constexpr int PT_OFF = 140288;
__device__ __forceinline__ int fresh_tid() { int t = threadIdx.x; asm volatile("" : "+v"(t)); return t; }
#define TIDS const int tid = fresh_tid(), lane = tid & 63, wave = __builtin_amdgcn_readfirstlane(tid >> 6)
struct Ctx {
    LAS unsigned char* lds; int G, bid; float* out; unsigned char* ws;
    __device__ __forceinline__ const float* in(int k) const { const u32x2 v = *(const LAS u32x2*)(lds + PT_OFF + 8 * k);
        const unsigned lo = __builtin_amdgcn_readfirstlane(v.x), hi = __builtin_amdgcn_readfirstlane(v.y); return (const float*)(const GAS float*)(((unsigned long long)hi << 32) | lo); }
    __device__ __forceinline__ float* mod() const { return (float*)(ws + WS_MOD); }
    __device__ __forceinline__ float* ropec() const { return (float*)(ws + WS_ROPE); }
    __device__ __forceinline__ float* ropes() const { return (float*)(ws + WS_ROPE) + 1024 * 32; }
    __device__ __forceinline__ float* dtb() const { return (float*)(ws + WS_DT); }
    __device__ __forceinline__ float* lab() const { return (float*)(ws + WS_LA); }
    __device__ __forceinline__ bf16_t* krall() const { return (bf16_t*)(ws + WS_KR); }
    __device__ __forceinline__ bf16_t* ckvall() const { return (bf16_t*)(ws + WS_CKV); }
    __device__ __forceinline__ bf16_t* qc() const { return (bf16_t*)(ws + WS_QC); }
    __device__ __forceinline__ bf16_t* qb() const { return (bf16_t*)(ws + WS_Q); }
    __device__ __forceinline__ bf16_t* kvb() const { return (bf16_t*)(ws + WS_KV); }
    __device__ __forceinline__ bf16_t* xbc() const { return (bf16_t*)(ws + WS_XBC); }
    __device__ __forceinline__ bf16_t* yssd() const { return (bf16_t*)(ws + WS_YSSD); }
    __device__ __forceinline__ bf16_t* yret() const { return (bf16_t*)(ws + WS_YRET); }
    __device__ __forceinline__ bf16_t* abuf() const { return (bf16_t*)(ws + WS_ABUF); }
    __device__ __forceinline__ bf16_t* ub() const { return (bf16_t*)(ws + WS_U); }
    __device__ __forceinline__ bf16_t* wts() const { return (bf16_t*)(ws + WS_W); }
    __device__ __forceinline__ bf16_t* xb() const { return (bf16_t*)(ws + WS_XB); }
};

__device__ __forceinline__ float bf2f(unsigned v) { return __uint_as_float(v << 16); }
__device__ __forceinline__ float bflo(unsigned w) { return __uint_as_float(w << 16); }
__device__ __forceinline__ float bfhi(unsigned w) { return __uint_as_float(w & 0xffff0000u); }
__device__ __forceinline__ unsigned pk2(float lo, float hi) { return pg8::cvt_pk_bf16(lo, hi); }
template <int CTRL> __device__ __forceinline__ float dppf(float v) { return __builtin_bit_cast(float, __builtin_amdgcn_update_dpp(0, __builtin_bit_cast(int, v), CTRL, 0xf, 0xf, false)); }
__device__ __forceinline__ float row16_sum(float v) { v += dppf<0x128>(v); v += dppf<0x124>(v); v += dppf<0x122>(v); v += dppf<0x121>(v); return v; }
__device__ __forceinline__ float rlane(float v, int l) { return __builtin_bit_cast(float, __builtin_amdgcn_readlane(__builtin_bit_cast(int, v), l)); }
__device__ __forceinline__ float wave_sum(float v) { v = row16_sum(v); return (rlane(v, 0) + rlane(v, 16)) + (rlane(v, 32) + rlane(v, 48)); }
__device__ __forceinline__ int cond_of_row(int r) { return r < NCTXR ? 0 : 1 + ((r - NCTXR) >> 10); }
__device__ __forceinline__ int xcd_tile(int bid) { return (bid & 7) * 32 + (bid >> 3); }
__device__ __forceinline__ int xcd_row(int v, int G) { if (G != 256) return v; const int bid = (v & 2047) >> 3; return xcd_tile(bid) * 64 + (v >> 11) * 8 + (v & 7); }


template <int MODE>
__device__ __forceinline__ void transpose_item(const float* W, int K, int N, bf16_t* WT, LAS float* scr, int item, int lane, int nblk) {
    const int kb = item / nblk, nb = item % nblk, k0 = 64 * kb, n0 = 32 * nb;
    const int ks = lane >> 3, ns = lane & 7, nn = n0 + 4 * ns; const bool ok = nn < N;
    f32x4 v[8];
#pragma unroll
    for (int i = 0; i < 8; ++i) v[i] = ok ? __builtin_nontemporal_load((const f32x4*)(W + (size_t)(k0 + i * 8 + ks) * N + nn)) : (f32x4){0.f, 0.f, 0.f, 0.f};
#pragma unroll
    for (int i = 0; i < 8; ++i) { LAS float* d = scr + (i * 8 + ks) * 33 + 4 * ns; d[0] = v[i].x; d[1] = v[i].y; d[2] = v[i].z; d[3] = v[i].w; }
    asm volatile("s_waitcnt lgkmcnt(0)" ::: "memory");
    const int c = lane & 7;
#pragma unroll
    for (int j = 0; j < 4; ++j) { const int nl = (lane >> 3) + 8 * j; const int n = n0 + nl; const LAS float* s = scr + (8 * c) * 33 + nl;
        int row = n;
        if (MODE == 1) { const int jj = n < 2816 ? n : n - 2816; row = 256 * (jj >> 7) + (jj & 127) + (n < 2816 ? 0 : 128); }
        u32x4 o; o.x = pk2(s[0 * 33], s[1 * 33]); o.y = pk2(s[2 * 33], s[3 * 33]); o.z = pk2(s[4 * 33], s[5 * 33]); o.w = pk2(s[6 * 33], s[7 * 33]);
        *(u32x4*)(WT + (size_t)row * K + k0 + 8 * c) = o; }
    asm volatile("s_waitcnt lgkmcnt(0)" ::: "memory");
}

__device__ __forceinline__ void convert_weights(Ctx& C, int l, int widx, int nw, int wave, int lane, int which = 0) {
    LAS float* scr = (LAS float*)(C.lds + wave * 8448);
    constexpr int I_IN = 16 * 88, I_OUT = 16 * 32, I_W1 = 16 * 176, I_W2 = 44 * 32, I_UQ = 4 * 16, I_UKV = 2 * 16, I_L = I_IN + I_OUT + I_W1 + I_W2 + I_UQ + I_UKV;
    bf16_t* wl = C.wts() + (size_t)l * WL_TOTAL;
    for (int it = widx; it < I_L; it += nw) {
        int r = it;
        { const int cls = (r >= I_IN && r < I_IN + I_OUT + I_W1) ? 2 : (r >= I_IN + I_OUT + I_W1 && r < I_IN + I_OUT + I_W1 + I_W2) ? 3 : 1; if (which != 0 && cls != which) continue; }
        if (r < I_IN) { transpose_item<0>(C.in(11) + (size_t)l * 1024 * 2736, 1024, 2736, wl + WL_IN, scr, r, lane, 88); continue; } r -= I_IN;
        if (r < I_OUT) { transpose_item<0>(C.in(24) + (size_t)l * 1024 * 1024, 1024, 1024, wl + WL_OUT, scr, r, lane, 32); continue; } r -= I_OUT;
        if (r < I_W1) { transpose_item<1>(C.in(26) + (size_t)l * 1024 * 5632, 1024, 5632, wl + WL_W1, scr, r, lane, 176); continue; } r -= I_W1;
        if (r < I_W2) { transpose_item<0>(C.in(27) + (size_t)l * 2816 * 1024, 2816, 1024, wl + WL_W2, scr, r, lane, 32); continue; } r -= I_W2;
        if (r < I_UQ) { transpose_item<0>(C.in(21) + (size_t)l * 256 * 384, 256, 384, wl + WL_UQ, scr, r, lane, 16); continue; } r -= I_UQ;
        transpose_item<0>(C.in(23) + (size_t)l * 128 * 512, 128, 512, wl + WL_UKV, scr, r, lane, 16);
    }
}

__device__ __forceinline__ void phase_prologue(Ctx& C) {
    TIDS;
    for (int i = C.bid * NTHR + tid; i < 1024 * 32; i += C.G * NTHR) {
        const int t = i >> 5, d = i & 31, i8 = d & 7; const float pos = (float)((d < 16) ? (t >> 6) : (t & 63));
        const float inv = exp2f(-(float)i8 * 0.125f * 13.287712379549449f);
        const float ang = pos * inv;
        const float k = rintf(ang * 0.15915494309189535f);
        float rr = fmaf(-k, 6.28125f, ang); rr = fmaf(-k, 1.9353071795864769e-3f, rr);
        C.ropec()[i] = cosf(rr); C.ropes()[i] = sinf(rr);
    }
    if (C.bid < 192) {
        LAS float* sc = (LAS float*)(C.lds);
        LAS float* red = (LAS float*)(C.lds + 36 * 1024);
        const float* cctx = C.in(7); const float* cc = C.in(2);
        for (int i = tid; i < 9 * 1024; i += NTHR) { const int cnd = i >> 10, k = i & 1023; const float v = cnd == 0 ? cctx[k] : cc[(cnd - 1) * 1024 + k]; sc[i] = v / (1.0f + __expf(-v)); }
        __syncthreads();
        for (int task = C.bid; task < 192; task += C.G) {
            const int l = task / 48, col0 = (task % 48) * 128;
            const float* W = C.in(8) + (size_t)l * 1024 * 6144 + col0 + 2 * lane + (size_t)(wave * 128) * 6144;
            f32x2 a[9];
#pragma unroll
            for (int q = 0; q < 9; ++q) a[q] = (f32x2){0.f, 0.f};
            for (int k8 = 0; k8 < 128; k8 += 8) {
                f32x2 w[8];
#pragma unroll
                for (int e = 0; e < 8; ++e) w[e] = __builtin_nontemporal_load((const f32x2*)(W + (size_t)(k8 + e) * 6144));
#pragma unroll
                for (int q = 0; q < 9; ++q) { const f32x4 s0 = *(const LAS f32x4*)(sc + q * 1024 + wave * 128 + k8), s1 = *(const LAS f32x4*)(sc + q * 1024 + wave * 128 + k8 + 4);
                    a[q] += w[0] * s0.x; a[q] += w[1] * s0.y; a[q] += w[2] * s0.z; a[q] += w[3] * s0.w; a[q] += w[4] * s1.x; a[q] += w[5] * s1.y; a[q] += w[6] * s1.z; a[q] += w[7] * s1.w; }
            }
#pragma unroll
            for (int q = 0; q < 9; ++q) *(LAS f32x2*)(red + (wave * 9 + q) * 128 + 2 * lane) = a[q];
            __syncthreads();
            const float* bada = C.in(9);
            for (int o = tid; o < 9 * 128; o += NTHR) { const int q = o >> 7, c = o & 127; float sum = 0.f;
#pragma unroll
                for (int z = 0; z < 8; ++z) sum += red[(z * 9 + q) * 128 + c];
                C.mod()[((size_t)l * 9 + q) * 6144 + col0 + c] = sum + bada[(size_t)l * 6144 + col0 + c]; }
            __syncthreads();
        }
    }
    __syncthreads();
    convert_weights(C, 0, C.bid * NWAVES + wave, C.G * NWAVES, wave, lane, 1);
}

template <int MODE>
__device__ __forceinline__ void phase_norm(Ctx& C, const float* xlo, const float* xhi, const float* w, const float* modl, int sh_off, int sc_off) {
    TIDS;
    const int gw = C.bid * NWAVES + wave, NGW = C.G * NWAVES;
    f32x4 wv[4];
#pragma unroll
    for (int j = 0; j < 4; ++j) wv[j] = *(const f32x4*)(w + 4 * lane + 256 * j);
    for (int r0 = gw; r0 < NTOK; r0 += 2 * NGW) {
        f32x4 v[2][4]; int rr[2];
#pragma unroll
        for (int q = 0; q < 2; ++q) { const int r = xcd_row(r0 + q * NGW < NTOK ? r0 + q * NGW : r0, C.G); rr[q] = r;
            const float* xr = r < NCTXR ? xlo + (size_t)r * DM : xhi + (size_t)(r - NCTXR) * DM;
#pragma unroll
            for (int j = 0; j < 4; ++j) v[q][j] = *(const f32x4*)(xr + 4 * lane + 256 * j); }
#pragma unroll
        for (int q = 0; q < 2; ++q) { const int r = rr[q]; float s = 0.f;
#pragma unroll
            for (int j = 0; j < 4; ++j) s += (v[q][j].x * v[q][j].x + v[q][j].y * v[q][j].y) + (v[q][j].z * v[q][j].z + v[q][j].w * v[q][j].w);
            const float rstd = rsqrtf(wave_sum(s) * (1.f / DM) + EPS);
            if (MODE == 0) {
                const float* m = modl + cond_of_row(r) * 6144;
#pragma unroll
                for (int j = 0; j < 4; ++j) { const int c = 4 * lane + 256 * j; const f32x4 scv = *(const f32x4*)(m + sc_off + c), shv = *(const f32x4*)(m + sh_off + c);
                    const f32x4 h = v[q][j] * rstd * wv[j] * (scv + 1.0f) + shv;
                    u32x2 o; o.x = pk2(h.x, h.y); o.y = pk2(h.z, h.w); *(u32x2*)(C.abuf() + (size_t)r * DM + c) = o; }
            } else {
#pragma unroll
                for (int j = 0; j < 4; ++j) { const int c = 4 * lane + 256 * j; *(f32x4*)(C.out + (size_t)r * DM + c) = v[q][j] * rstd * wv[j]; }
            }
        }
    }
}

template <int MODE>
__device__ __forceinline__ void phase_norm_b(Ctx& C, const float* w, const float* modl, int sh_off, int sc_off) {
    TIDS;
    const int gw = C.bid * NWAVES + wave, NGW = C.G * NWAVES;
    f32x4 wv[2][2];
#pragma unroll
    for (int j = 0; j < 2; ++j) { wv[j][0] = *(const f32x4*)(w + 8 * lane + 512 * j); wv[j][1] = *(const f32x4*)(w + 8 * lane + 512 * j + 4); }
    for (int r0 = gw; r0 < NTOK; r0 += 8 * NGW) {
        u32x4 raw[8][2]; int rr[8];
#pragma unroll
        for (int q = 0; q < 8; ++q) { const int r = xcd_row(r0 + q * NGW < NTOK ? r0 + q * NGW : r0, C.G); rr[q] = r;
#pragma unroll
            for (int j = 0; j < 2; ++j) raw[q][j] = *(const u32x4*)(C.xb() + (size_t)r * DM + 8 * lane + 512 * j); }
#pragma unroll
        for (int q = 0; q < 8; ++q) { const int r = rr[q]; f32x4 v[2][2]; float s = 0.f;
#pragma unroll
            for (int j = 0; j < 2; ++j) { const u32x4 x = raw[q][j]; v[j][0] = (f32x4){bflo(x.x), bfhi(x.x), bflo(x.y), bfhi(x.y)}; v[j][1] = (f32x4){bflo(x.z), bfhi(x.z), bflo(x.w), bfhi(x.w)};
#pragma unroll
                for (int hh = 0; hh < 2; ++hh) s += (v[j][hh].x * v[j][hh].x + v[j][hh].y * v[j][hh].y) + (v[j][hh].z * v[j][hh].z + v[j][hh].w * v[j][hh].w); }
            const float rstd = rsqrtf(wave_sum(s) * (1.f / DM) + EPS);
            if (MODE == 0) {
                const float* m = modl + cond_of_row(r) * 6144;
#pragma unroll
                for (int j = 0; j < 2; ++j) { const int c = 8 * lane + 512 * j; f32x4 h[2];
#pragma unroll
                    for (int hh = 0; hh < 2; ++hh) { const f32x4 scv = *(const f32x4*)(m + sc_off + c + 4 * hh), shv = *(const f32x4*)(m + sh_off + c + 4 * hh); h[hh] = v[j][hh] * rstd * wv[j][hh] * (scv + 1.0f) + shv; }
                    u32x4 o; o.x = pk2(h[0].x, h[0].y); o.y = pk2(h[0].z, h[0].w); o.z = pk2(h[1].x, h[1].y); o.w = pk2(h[1].z, h[1].w); *(u32x4*)(C.abuf() + (size_t)r * DM + c) = o; }
            } else {
#pragma unroll
                for (int j = 0; j < 2; ++j) { const int c = 8 * lane + 512 * j;
#pragma unroll
                    for (int hh = 0; hh < 2; ++hh) *(f32x4*)(C.out + (size_t)r * DM + c + 4 * hh) = v[j][hh] * rstd * wv[j][hh]; }
            }
        }
    }
}

#define MFMA16P(x, y, c) __builtin_amdgcn_mfma_f32_16x16x32_bf16((x), (y), (c), 0, 0, 0)
constexpr int PP_QC = 0, PP_CKV = 33792;
__device__ __forceinline__ void phase_prep(Ctx& C, int layer) {
    TIDS; const int fr = lane & 15, fq = lane >> 4;
    LAS bf16_t* sQC = (LAS bf16_t*)(C.lds + PP_QC); LAS bf16_t* sCKV = (LAS bf16_t*)(C.lds + PP_CKV);
    const float* cw = C.in(12) + (size_t)layer * 5 * 768; const float* cb = C.in(13) + (size_t)layer * 768;
    const f32x4 qnw = *(const f32x4*)(C.in(20) + layer * 256 + 4 * lane); const f32x2 kvnw = *(const f32x2*)(C.in(22) + layer * 128 + 2 * lane);
    const float dtbias = C.in(14)[layer * 16 + (lane & 15)], aexp = __expf(C.in(15)[layer * 16 + (lane & 15)]);
    const bf16_t* wl = C.wts() + (size_t)layer * WL_TOTAL;
    for (int tile_ = C.bid; tile_ < NTOK / 64; tile_ += C.G) { const int tile = C.G == 256 ? xcd_tile(tile_) : tile_;
        __syncthreads();
        f32x2 cv[2], ck[2];
#pragma unroll
        for (int q = 0; q < 2; ++q) { const int idx = 16 * tile + 2 * wave + q, b = idx >> 9, sx = idx & 511;
            cv[q] = *(const f32x2*)(C.in(5) + (((size_t)b * DEPTH + layer) * 512 + sx) * 128 + 2 * lane);
            ck[q] = *(const f32x2*)(C.in(6) + (((size_t)b * DEPTH + layer) * 512 + sx) * 32 + 2 * (lane & 15)); }
        const int r0 = tile * 64 + wave * 8; const bool ctx = r0 < NCTXR; const int b = ctx ? (r0 >> 8) : ((r0 - NCTXR) >> 10), t0 = ctx ? (r0 & 255) : ((r0 - NCTXR) & 1023), L = ctx ? 256 : 1024;
        const bf16_t* u0 = C.ub() + (size_t)r0 * UP;
        unsigned rdt[8]; u32x2 rq[8]; unsigned rkv[8]; unsigned rkr[8];
#pragma unroll
        for (int j = 0; j < 8; ++j) { const bf16_t* ur = u0 + (size_t)j * UP; rdt[j] = ur[U_DT + (lane & 15)]; rq[j] = *(const u32x2*)(ur + U_MQ + 4 * lane); rkv[j] = *(const unsigned*)(ur + U_MKV + 2 * lane); rkr[j] = ur[U_MKR + (lane & 31)]; }
        {
            int lane_ = lane; asm volatile("" : "+v"(lane_)); const int lane = lane_;
            u32x2 raw[12][3];
#pragma unroll
            for (int j = 0; j < 12; ++j) { const int tt = t0 + j - 2; const bool ok = tt >= 0 && tt < L;
#pragma unroll
                for (int c3 = 0; c3 < 3; ++c3) raw[j][c3] = ok ? *(const u32x2*)((u0 - 2 * UP) + (unsigned)(j * UP + U_XBC + 4 * lane + 256 * c3)) : (u32x2){0u, 0u}; }
#pragma unroll
            for (int c3 = 0; c3 < 3; ++c3) { const unsigned ch = 4 * lane + 256 * c3; const f32x4 bias = *(const f32x4*)(cb + ch); f32x4 wv[5];
#pragma unroll
                for (int w = 0; w < 5; ++w) wv[w] = *(const f32x4*)(cw + (w * 768u + ch));
#pragma unroll
                for (int j = 0; j < 8; ++j) { f32x4 acc = bias;
#pragma unroll
                    for (int w = 0; w < 5; ++w) { const u32x2 rw = raw[j + w][c3]; acc.x += bflo(rw.x) * wv[w].x; acc.y += bfhi(rw.x) * wv[w].y; acc.z += bflo(rw.y) * wv[w].z; acc.w += bfhi(rw.y) * wv[w].w; }
                    u32x2 o; o.x = pk2(pg8::silu_f(acc.x), pg8::silu_f(acc.y)); o.y = pk2(pg8::silu_f(acc.z), pg8::silu_f(acc.w)); *(u32x2*)((C.xbc() + (size_t)(r0 + j) * 768) + ch) = o; } }
        }
        { int lane_ = lane; asm volatile("" : "+v"(lane_)); const int lane = lane_;
#pragma unroll
        for (int q = 0; q < 2; ++q) { const int idx = 16 * tile + 2 * wave + q, b = idx >> 9, sx = idx & 511; const size_t krow = 8192 + (size_t)b * 1536 + sx;
            *(LAS unsigned*)(sCKV + (64 + 2 * wave + q) * 136 + 2 * lane) = pk2(cv[q].x, cv[q].y);
            if (lane < 16) *(unsigned*)(C.krall() + krow * 32 + 2 * lane) = pk2(ck[q].x, ck[q].y); }
#pragma unroll
        for (int j = 0; j < 8; ++j) { const int r = r0 + j, t = t0 + j;
            if (lane < 16) { const float v = bf2f(rdt[j]) + dtbias; const float dt = v > 20.f ? v : 0.6931471805599453f * __builtin_amdgcn_logf(1.0f + __builtin_amdgcn_exp2f(1.4426950408889634f * v)); C.dtb()[(size_t)r * 16 + lane] = dt; C.lab()[(size_t)r * 16 + lane] = -dt * aexp; }
            { const float x0 = bflo(rq[j].x), x1 = bfhi(rq[j].x), x2 = bflo(rq[j].y), x3 = bfhi(rq[j].y);
              const float rstd = rsqrtf(wave_sum(x0 * x0 + x1 * x1 + x2 * x2 + x3 * x3) * (1.f / 256) + EPS);
              u32x2 o; o.x = pk2(x0 * rstd * qnw.x, x1 * rstd * qnw.y); o.y = pk2(x2 * rstd * qnw.z, x3 * rstd * qnw.w); *(LAS u32x2*)(sQC + (wave * 8 + j) * 264 + 4 * lane) = o; }
            const size_t krow = ctx ? (size_t)r : 8192 + (size_t)b * 1536 + 512 + t;
            { const float x0 = bflo(rkv[j]), x1 = bfhi(rkv[j]); const float rstd = rsqrtf(wave_sum(x0 * x0 + x1 * x1) * (1.f / 128) + EPS);
              const float y0 = x0 * rstd * kvnw.x, y1 = x1 * rstd * kvnw.y; *(LAS unsigned*)(sCKV + (wave * 8 + j) * 136 + 2 * lane) = pk2(y0, y1);
              if (ctx) *(f32x2*)(C.out + O_CKV + (((size_t)b * DEPTH + layer) * 256 + t) * 128 + 2 * lane) = (f32x2){y0, y1}; }
            { const float v = bf2f(rkr[j]); const float partner = dppf<0x128>(v); float o = v;
              if (!ctx) { const float rot = (lane & 8) ? partner : -partner; o = v * C.ropec()[t * 32 + (lane & 31)] + rot * C.ropes()[t * 32 + (lane & 31)]; }
              if (lane < 32) { C.krall()[krow * 32 + lane] = (bf16_t)(pk2(o, 0.f) & 0xffffu); if (ctx) C.out[O_KR + (((size_t)b * DEPTH + layer) * 256 + t) * 32 + lane] = v; } }
        }
        }
        __syncthreads();
        __builtin_amdgcn_sched_barrier(0);
        {
            int lane_ = lane; asm volatile("" : "+v"(lane_)); const int fr = lane_ & 15, fq = lane_ >> 4;
            const bf16_t* Bq = wl + WL_UQ + (unsigned)((48 * wave + fr) * 256 + fq * 8);
            f32x4 acc[4][3];
#pragma unroll
            for (int mt = 0; mt < 4; ++mt)
#pragma unroll
                for (int j = 0; j < 3; ++j) acc[mt][j] = (f32x4){0.f, 0.f, 0.f, 0.f};
#pragma unroll
            for (int kh = 0; kh < 2; ++kh) {
                bf16x8 xq[3][4];
#pragma unroll
                for (int j = 0; j < 3; ++j)
#pragma unroll
                    for (int k4 = 0; k4 < 4; ++k4) xq[j][k4] = *(const bf16x8*)(Bq + (j * 16 * 256 + (4 * kh + k4) * 32));
                __builtin_amdgcn_sched_barrier(0);
#pragma unroll
                for (int k4 = 0; k4 < 4; ++k4) { const int kk = 4 * kh + k4; bf16x8 ya[4];
#pragma unroll
                    for (int mt = 0; mt < 4; ++mt) ya[mt] = *(const LAS bf16x8*)(sQC + (16 * mt + fr) * 264 + kk * 32 + fq * 8);
#pragma unroll
                    for (int mt = 0; mt < 4; ++mt)
#pragma unroll
                        for (int j = 0; j < 3; ++j) acc[mt][j] = MFMA16P(xq[j][k4], ya[mt], acc[mt][j]); }
                __builtin_amdgcn_sched_barrier(0);
            }
#pragma unroll
            for (int mt = 0; mt < 4; ++mt) { bf16_t* qrow = C.qb() + (unsigned)((tile * 64 + 16 * mt + fr) * 512 + 48 * wave + 4 * fq);
#pragma unroll
                for (int j = 0; j < 3; ++j) { u32x2 o; o.x = pk2(acc[mt][j][0], acc[mt][j][1]); o.y = pk2(acc[mt][j][2], acc[mt][j][3]); *(u32x2*)(qrow + 16 * j) = o; } }
        }
        {
            __builtin_amdgcn_sched_barrier(0);
            int lane_ = lane; asm volatile("" : "+v"(lane_)); const int fr = lane_ & 15, fq = lane_ >> 4;
            const bf16_t* Bk = wl + WL_UKV + (unsigned)((64 * wave + fr) * 128 + fq * 8);
            bf16x8 xk[4][4];
#pragma unroll
            for (int j = 0; j < 4; ++j)
#pragma unroll
                for (int kk = 0; kk < 4; ++kk) xk[j][kk] = *(const bf16x8*)(Bk + (j * 16 * 128 + kk * 32));
            f32x4 acc[5][4];
#pragma unroll
            for (int mt = 0; mt < 5; ++mt)
#pragma unroll
                for (int j = 0; j < 4; ++j) acc[mt][j] = (f32x4){0.f, 0.f, 0.f, 0.f};
#pragma unroll
            for (int kk = 0; kk < 4; ++kk) { bf16x8 ya[5];
#pragma unroll
                for (int mt = 0; mt < 5; ++mt) ya[mt] = *(const LAS bf16x8*)(sCKV + (16 * mt + fr) * 136 + kk * 32 + fq * 8);
#pragma unroll
                for (int mt = 0; mt < 5; ++mt)
#pragma unroll
                    for (int j = 0; j < 4; ++j) acc[mt][j] = MFMA16P(xk[j][kk], ya[mt], acc[mt][j]); }
#pragma unroll
            for (int mt = 0; mt < 5; ++mt) { unsigned krow;
                if (mt < 4) { const int r = tile * 64 + 16 * mt + fr; krow = r < NCTXR ? (unsigned)r : 8192u + (unsigned)(((r - NCTXR) >> 10) * 1536 + 512 + ((r - NCTXR) & 1023)); }
                else { const int idx = 16 * tile + fr; krow = 8192u + (unsigned)((idx >> 9) * 1536 + (idx & 511)); }
                bf16_t* kvrow = C.kvb() + (krow * 512u + (unsigned)(64 * wave + 4 * fq));
#pragma unroll
                for (int j = 0; j < 4; ++j) { u32x2 o; o.x = pk2(acc[mt][j][0], acc[mt][j][1]); o.y = pk2(acc[mt][j][2], acc[mt][j][3]); *(u32x2*)(kvrow + 16 * j) = o; } }
        }
    }
}

#define LDS_BARRIER() do { asm volatile("s_waitcnt lgkmcnt(0)" ::: "memory"); __builtin_amdgcn_s_barrier(); asm volatile("" ::: "memory"); } while (0)
#define SCHED_FENCE() __builtin_amdgcn_sched_barrier(0)
#define MFMA16(x, y, c) __builtin_amdgcn_mfma_f32_16x16x32_bf16((x), (y), (c), 0, 0, 0)
constexpr int SC_Q = 0, SC_K = 18432, SC_KT = 36864, SC_VT = 54272, SC_P = 71680, SC_Q2 = 106496, SC_HT = 124928, SC_CUM = 134144, SC_LA = 134656, SC_DT = 135168;

__device__ __forceinline__ void scan_unit(Ctx& C, int layer, int kind  , bool ctx, int b, int h, int dir) {
    LAS unsigned char* lds = C.lds;
    TIDS; const int wid = wave, fr = lane & 15, fq = lane >> 4;
    const int L = ctx ? 256 : 1024, R0 = ctx ? b * 256 : NCTXR + b * 1024, nch = L >> 7;
    const bf16_t *qp, *kp, *vp; int pitch; float kscale, la_const = 0.f; bf16_t* yout; int ypitch; int NH;
    if (kind == 0) { const int g = h >> 2; qp = C.xbc() + 640 + g * 64; kp = C.xbc() + 512 + g * 64; vp = C.xbc() + h * 64; pitch = 768; kscale = 1.f;
        yout = C.yssd() + (size_t)dir * NTOK * 512 + h * 64; ypitch = 512; NH = 8; }
    else { qp = C.ub() + U_RQ + h * 64; kp = C.ub() + U_RK + h * 64; vp = C.ub() + U_RV + h * 64; pitch = UP; kscale = 0.125f;
        const float x = C.in(18)[layer * 8 + dir * 4 + h]; la_const = -log1pf(__expf(-x));
        yout = C.yret() + (size_t)dir * NTOK * 256 + h * 64; ypitch = 256; NH = 4; }
    const float* labp = C.lab() + dir * 8 + h; const float* dtbp = C.dtb() + dir * 8 + h;
    LAS bf16_t* sQ = (LAS bf16_t*)(lds + SC_Q); LAS bf16_t* sK = (LAS bf16_t*)(lds + SC_K); LAS bf16_t* sKT = (LAS bf16_t*)(lds + SC_KT); LAS bf16_t* sVT = (LAS bf16_t*)(lds + SC_VT);
    LAS bf16_t* sP = (LAS bf16_t*)(lds + SC_P); LAS bf16_t* sQ2 = (LAS bf16_t*)(lds + SC_Q2); LAS bf16_t* sHT = (LAS bf16_t*)(lds + SC_HT);
    LAS float* sCumAll = (LAS float*)(lds + SC_CUM);
    const int tn = wid >> 1, tp0 = (wid & 1) * 2;
    f32x4 Hacc[2];
    if (!ctx) { const float* st = (kind == 0 ? C.in(3) : C.in(4)) + ((((size_t)b * DEPTH + layer) * 2 + dir) * NH + h) * 4096;
#pragma unroll
        for (int q = 0; q < 2; ++q)
#pragma unroll
            for (int e = 0; e < 4; ++e) Hacc[q][e] = __builtin_nontemporal_load(st + (16 * tn + 4 * fq + e) * 64 + 16 * (tp0 + q) + fr); }
    else { Hacc[0] = (f32x4){0.f, 0.f, 0.f, 0.f}; Hacc[1] = Hacc[0]; }
    const int li = tid >> 3, p8 = tid & 7;
    u32x4 qv[2], kv[2], vv[2]; float dt_r[2];
#define SCAN_ISSUE(cc) do { _Pragma("unroll") for (int ps_ = 0; ps_ < 2; ++ps_) { const int pos_ = (cc) * 128 + li + 64 * ps_, t_ = dir ? L - 1 - pos_ : pos_; const size_t r_ = (size_t)(R0 + t_); \
        qv[ps_] = *(const u32x4*)(qp + r_ * pitch + p8 * 8); kv[ps_] = *(const u32x4*)(kp + r_ * pitch + p8 * 8); vv[ps_] = *(const u32x4*)(vp + r_ * pitch + p8 * 8); \
        dt_r[ps_] = kind == 0 ? dtbp[r_ * 16] : 1.0f; } } while (0)
    float cs_e = 0.f, cs_o = 0.f;
    if (wid < nch) { float a[2];
#pragma unroll
        for (int e = 0; e < 2; ++e) { const int pos = wid * 128 + 2 * lane + e, t = dir ? L - 1 - pos : pos; a[e] = (kind == 0 ? labp[(size_t)(R0 + t) * 16] : la_const) * 1.4426950408889634f; }
        float sc = a[0] + a[1];
#pragma unroll
        for (int o = 1; o < 64; o <<= 1) { const float v = __shfl_up(sc, o); if (lane >= o) sc += v; }
        cs_o = sc; cs_e = sc - a[1]; }
    SCAN_ISSUE(0);
    __syncthreads();
#pragma unroll
    for (int q = 0; q < 2; ++q) { u32x2 o; o.x = pk2(Hacc[q][0], Hacc[q][1]); o.y = pk2(Hacc[q][2], Hacc[q][3]); *(LAS u32x2*)(sHT + (16 * (tp0 + q) + fr) * 72 + 16 * tn + 4 * fq) = o; }
    if (wid < nch) *(LAS f32x2*)(sCumAll + wid * 128 + 2 * lane) = (f32x2){cs_e, cs_o};
    __syncthreads();
    for (int c = 0; c < nch; ++c) {
        const LAS float* sCum = sCumAll + c * 128;
        float cum_i[2]; const float cum_last = sCum[127];
#pragma unroll
        for (int ps = 0; ps < 2; ++ps) cum_i[ps] = sCum[li + 64 * ps];
#pragma unroll
        for (int ps = 0; ps < 2; ++ps) {
            const int i = li + 64 * ps, isw = i ^ (8 * p8);
            const float te = __builtin_amdgcn_exp2f(cum_last - cum_i[ps]) * kscale, dtv = dt_r[ps];
            *(LAS u32x4*)(sQ + i * 72 + p8 * 8) = qv[ps]; *(LAS u32x4*)(sK + i * 72 + p8 * 8) = kv[ps];
            const unsigned ka[4] = {kv[ps].x, kv[ps].y, kv[ps].z, kv[ps].w}, va[4] = {vv[ps].x, vv[ps].y, vv[ps].z, vv[ps].w};
#pragma unroll
            for (int e = 0; e < 4; ++e) {
                const unsigned kt = pk2(bflo(ka[e]) * te, bfhi(ka[e]) * te), vt = pk2(bflo(va[e]) * dtv, bfhi(va[e]) * dtv);
                sKT[(p8 * 8 + 2 * e) * 136 + isw] = (bf16_t)(kt & 0xffffu); sKT[(p8 * 8 + 2 * e + 1) * 136 + isw] = (bf16_t)(kt >> 16);
                sVT[(p8 * 8 + 2 * e) * 136 + isw] = (bf16_t)(vt & 0xffffu); sVT[(p8 * 8 + 2 * e + 1) * 136 + isw] = (bf16_t)(vt >> 16); }
        }
        if (c + 1 < nch) SCAN_ISSUE(c + 1);
        LDS_BARRIER();
        {
            const float kadj = kind == 0 ? 0.f : -3.f;
            int prt[5], pjt[5];
#pragma unroll
            for (int t = 0; t < 5; ++t) { const int p = wid + 8 * t; int rt = 0;
#pragma unroll
                for (int k = 1; k < 8; ++k) if (p >= k * (k + 1) / 2) rt = k;
                prt[t] = rt; pjt[t] = p - rt * (rt + 1) / 2; }
            {
                bf16x8 yq[4][2], xk[4][2]; f32x4 cj[4], s4[4]; float cumr[4];
#pragma unroll
                for (int t = 0; t < 4; ++t) { const int i = 16 * prt[t] + fr, jr = 16 * pjt[t] + fr;
                    yq[t][0] = *(const LAS bf16x8*)(sQ + i * 72 + fq * 8); yq[t][1] = *(const LAS bf16x8*)(sQ + i * 72 + 32 + fq * 8);
                    xk[t][0] = *(const LAS bf16x8*)(sK + jr * 72 + fq * 8); xk[t][1] = *(const LAS bf16x8*)(sK + jr * 72 + 32 + fq * 8);
                    cj[t] = *(const LAS f32x4*)(sCum + 16 * pjt[t] + 4 * fq); cumr[t] = sCum[i] + kadj; }
                SCHED_FENCE();
#pragma unroll
                for (int t = 0; t < 4; ++t) s4[t] = MFMA16(xk[t][0], yq[t][0], ((f32x4){0.f, 0.f, 0.f, 0.f}));
#pragma unroll
                for (int t = 0; t < 4; ++t) s4[t] = MFMA16(xk[t][1], yq[t][1], s4[t]);
                SCHED_FENCE();
#pragma unroll
                for (int t = 0; t < 4; ++t) { const int i = 16 * prt[t] + fr; float pv[4];
                    if (prt[t] == pjt[t]) {
#pragma unroll
                        for (int e = 0; e < 4; ++e) { const int j = 16 * pjt[t] + 4 * fq + e; pv[e] = s4[t][e] * __builtin_amdgcn_exp2f(j <= i ? cumr[t] - cj[t][e] : -1e30f); } }
                    else {
#pragma unroll
                        for (int e = 0; e < 4; ++e) pv[e] = s4[t][e] * __builtin_amdgcn_exp2f(cumr[t] - cj[t][e]); }
                    u32x2 o; o.x = pk2(pv[0], pv[1]); o.y = pk2(pv[2], pv[3]); *(LAS u32x2*)(sP + i * 136 + 16 * pjt[t] + 4 * fq) = o; }
            }
            if (wid < 4) {
                const int i = 16 * prt[4] + fr, jr = 16 * pjt[4] + fr;
                const bf16x8 y0 = *(const LAS bf16x8*)(sQ + i * 72 + fq * 8), y1 = *(const LAS bf16x8*)(sQ + i * 72 + 32 + fq * 8);
                const bf16x8 x0 = *(const LAS bf16x8*)(sK + jr * 72 + fq * 8), x1 = *(const LAS bf16x8*)(sK + jr * 72 + 32 + fq * 8);
                const f32x4 cj = *(const LAS f32x4*)(sCum + 16 * pjt[4] + 4 * fq); const float cumr = sCum[i] + kadj;
                f32x4 s4 = MFMA16(x0, y0, ((f32x4){0.f, 0.f, 0.f, 0.f})); s4 = MFMA16(x1, y1, s4);
                float pv[4];
#pragma unroll
                for (int e = 0; e < 4; ++e) { const int j = 16 * pjt[4] + 4 * fq + e; pv[e] = s4[e] * __builtin_amdgcn_exp2f(j <= i ? cumr - cj[e] : -1e30f); }
                u32x2 o; o.x = pk2(pv[0], pv[1]); o.y = pk2(pv[2], pv[3]); *(LAS u32x2*)(sP + i * 136 + 16 * pjt[4] + 4 * fq) = o;
            } else {
                const int rt = 2 * (wid - 4); *(LAS u32x2*)(sP + (16 * rt + fr) * 136 + 16 * (rt + 1) + 4 * fq) = (u32x2){0u, 0u};
            }
        }
        LDS_BARRIER();
        {
            const int i = 16 * wid + fr; f32x4 acc[4];
            {
                bf16x8 yq[2], xh[2][4], yp, xv[4]; f32x4 ah[4];
#pragma unroll
                for (int kk = 0; kk < 2; ++kk) { yq[kk] = *(const LAS bf16x8*)(sQ + i * 72 + kk * 32 + fq * 8);
#pragma unroll
                    for (int pt = 0; pt < 4; ++pt) xh[kk][pt] = *(const LAS bf16x8*)(sHT + (16 * pt + fr) * 72 + kk * 32 + fq * 8); }
                yp = *(const LAS bf16x8*)(sP + i * 136 + fq * 8);
#pragma unroll
                for (int pt = 0; pt < 4; ++pt) xv[pt] = *(const LAS bf16x8*)(sVT + (16 * pt + fr) * 136 + ((fq * 8) ^ (8 * ((2 * pt + (fr >> 3)) & 7))));
                const float ecr = __builtin_amdgcn_exp2f(sCum[i]);
                SCHED_FENCE();
#pragma unroll
                for (int pt = 0; pt < 4; ++pt) ah[pt] = MFMA16(xh[0][pt], yq[0], ((f32x4){0.f, 0.f, 0.f, 0.f}));
#pragma unroll
                for (int pt = 0; pt < 4; ++pt) acc[pt] = MFMA16(xv[pt], yp, ((f32x4){0.f, 0.f, 0.f, 0.f}));
#pragma unroll
                for (int pt = 0; pt < 4; ++pt) ah[pt] = MFMA16(xh[1][pt], yq[1], ah[pt]);
                SCHED_FENCE();
#pragma unroll
                for (int pt = 0; pt < 4; ++pt) acc[pt] = acc[pt] + ah[pt] * ecr;
            }
#define SCAN_PV_STEP(kk_) do { bf16x8 yp_ = *(const LAS bf16x8*)(sP + i * 136 + (kk_) * 32 + fq * 8); bf16x8 xv_[4]; \
                _Pragma("unroll") for (int pt = 0; pt < 4; ++pt) xv_[pt] = *(const LAS bf16x8*)(sVT + (16 * pt + fr) * 136 + (((kk_) * 32 + fq * 8) ^ (8 * ((2 * pt + (fr >> 3)) & 7)))); \
                SCHED_FENCE(); \
                _Pragma("unroll") for (int pt = 0; pt < 4; ++pt) acc[pt] = MFMA16(xv_[pt], yp_, acc[pt]); \
                SCHED_FENCE(); } while (0)
            if (wid >= 2) SCAN_PV_STEP(1);
            if (wid >= 4) SCAN_PV_STEP(2);
            if (wid >= 6) SCAN_PV_STEP(3);
#undef SCAN_PV_STEP
            const int pos = c * 128 + i, t = dir ? L - 1 - pos : pos; bf16_t* yr = yout + (size_t)(R0 + t) * ypitch;
#pragma unroll
            for (int pt = 0; pt < 4; ++pt) { u32x2 o; o.x = pk2(acc[pt][0], acc[pt][1]); o.y = pk2(acc[pt][2], acc[pt][3]); *(u32x2*)(yr + 16 * pt + 4 * fq) = o; }
        }
        {
            const float dec = __builtin_amdgcn_exp2f(cum_last);
            bf16x8 xk[4], yv[2][4];
#pragma unroll
            for (int kk = 0; kk < 4; ++kk) { xk[kk] = *(const LAS bf16x8*)(sKT + (16 * tn + fr) * 136 + ((kk * 32 + fq * 8) ^ (8 * ((2 * tn + (fr >> 3)) & 7))));
#pragma unroll
                for (int q = 0; q < 2; ++q) yv[q][kk] = *(const LAS bf16x8*)(sVT + (16 * (tp0 + q) + fr) * 136 + ((kk * 32 + fq * 8) ^ (8 * ((2 * (tp0 + q) + (fr >> 3)) & 7)))); }
            Hacc[0] = Hacc[0] * dec; Hacc[1] = Hacc[1] * dec;
            SCHED_FENCE();
#pragma unroll
            for (int kk = 0; kk < 4; ++kk)
#pragma unroll
                for (int q = 0; q < 2; ++q) Hacc[q] = MFMA16(xk[kk], yv[q][kk], Hacc[q]);
            SCHED_FENCE();
        }
        LDS_BARRIER();
#pragma unroll
        for (int q = 0; q < 2; ++q) { u32x2 o; o.x = pk2(Hacc[q][0], Hacc[q][1]); o.y = pk2(Hacc[q][2], Hacc[q][3]); *(LAS u32x2*)(sHT + (16 * (tp0 + q) + fr) * 72 + 16 * tn + 4 * fq) = o; }
    }
#undef SCAN_ISSUE
    if (ctx) { float* so = C.out + (kind == 0 ? O_SSD : O_RET) + ((((size_t)b * DEPTH + layer) * 2 + dir) * NH + h) * 4096;
#pragma unroll
        for (int q = 0; q < 2; ++q)
#pragma unroll
            for (int e = 0; e < 4; ++e) so[(16 * tn + 4 * fq + e) * 64 + 16 * (tp0 + q) + fr] = Hacc[q][e]; }
}

constexpr int AT_K = 0, AT_VT = 26624, AT_BUF = 44032;
template <int MODE = 0>
__device__ __forceinline__ void attn_unit(Ctx& C, bool ctx, int b, int h, int qb) {
    LAS unsigned char* lds = C.lds;
    TIDS; const int wid = wave, fr = lane & 15, fq = lane >> 4;
    const int R0 = ctx ? b * 256 : NCTXR + b * 1024, KR0 = ctx ? b * 256 : 8192 + b * 1536, S = ctx ? 256 : 1536, nkt = S >> 7;
    const int tq = qb * 128 + 16 * wid + fr; const size_t rq = (size_t)(R0 + tq);
    const float SCL = 0.10206207261596577f * 1.4426950408889634f;
    const int lj = tid >> 3, p8 = tid & 7, rj = tid >> 2, rp = tid & 3;
    const bf16_t* kvbase = C.kvb() + (size_t)(KR0 + lj) * 512 + h * 128 + p8 * 8; const bf16_t* krbase = C.krall() + (size_t)(KR0 + rj) * 32 + rp * 8;
    u32x4 kn[2], vn[2], kr8;
#define ATT_ISSUE(kt_) do { const bf16_t* kvrow_ = kvbase + (size_t)(kt_) * 128 * 512; kn[0] = *(const u32x4*)(kvrow_); kn[1] = *(const u32x4*)(kvrow_ + 64 * 512); \
        vn[0] = *(const u32x4*)(kvrow_ + 64); vn[1] = *(const u32x4*)(kvrow_ + 64 * 512 + 64); kr8 = *(const u32x4*)(krbase + (size_t)(kt_) * 128 * 32); } while (0)
    ATT_ISSUE(0);
    bf16x8 qf[3];
    { const bf16_t* qrow = C.qb() + rq * 512 + h * 96;
#pragma unroll
      for (int kk = 0; kk < 3; ++kk) { const u32x4 raw = *(const u32x4*)(qrow + kk * 32 + fq * 8); float x[8] = {bflo(raw.x), bfhi(raw.x), bflo(raw.y), bfhi(raw.y), bflo(raw.z), bfhi(raw.z), bflo(raw.w), bfhi(raw.w)};
          if (kk == 2 && !ctx) {
#pragma unroll
              for (int e = 0; e < 8; ++e) { const float partner = __shfl_xor(x[e], 16); const float rot = (fq & 1) ? partner : -partner; const int d = fq * 8 + e;
                  x[e] = x[e] * C.ropec()[tq * 32 + d] + rot * C.ropes()[tq * 32 + d]; } }
          u32x4 o; o.x = pk2(x[0] * SCL, x[1] * SCL); o.y = pk2(x[2] * SCL, x[3] * SCL); o.z = pk2(x[4] * SCL, x[5] * SCL); o.w = pk2(x[6] * SCL, x[7] * SCL);
          qf[kk] = __builtin_bit_cast(bf16x8, o); } }
    float m_run = -1e30f, l_run = 0.f; f32x4 o[4];
#pragma unroll
    for (int pt = 0; pt < 4; ++pt) o[pt] = (f32x4){0.f, 0.f, 0.f, 0.f};
    __syncthreads();
    for (int kt = 0; kt < nkt; ++kt) {
        LAS bf16_t* sK = (LAS bf16_t*)(lds + (kt & 1) * AT_BUF + AT_K); LAS bf16_t* sVT = (LAS bf16_t*)(lds + (kt & 1) * AT_BUF + AT_VT);
        if (MODE != 2) { *(LAS u32x4*)(sK + rj * 104 + 64 + rp * 8) = kr8;
#pragma unroll
          for (int ps = 0; ps < 2; ++ps) { const int j = lj + 64 * ps, jsw = j ^ (8 * p8); *(LAS u32x4*)(sK + j * 104 + p8 * 8) = kn[ps];
              const unsigned va[4] = {vn[ps].x, vn[ps].y, vn[ps].z, vn[ps].w};
#pragma unroll
              for (int e = 0; e < 4; ++e) { sVT[(p8 * 8 + 2 * e) * 136 + jsw] = (bf16_t)(va[e] & 0xffffu); sVT[(p8 * 8 + 2 * e + 1) * 136 + jsw] = (bf16_t)(va[e] >> 16); } } }
        if (MODE != 2 && kt + 1 < nkt) ATT_ISSUE(kt + 1);
        LDS_BARRIER();
        if (MODE == 1) continue;
        f32x4 s[8]; float mx = -1e30f;
        {
            bf16x8 kf[8][3];
#pragma unroll
            for (int jt = 0; jt < 8; ++jt)
#pragma unroll
                for (int kk = 0; kk < 3; ++kk) kf[jt][kk] = *(const LAS bf16x8*)(sK + (16 * jt + fr) * 104 + kk * 32 + fq * 8);
            SCHED_FENCE();
#pragma unroll
            for (int jt = 0; jt < 8; ++jt) s[jt] = MFMA16(kf[jt][0], qf[0], ((f32x4){0.f, 0.f, 0.f, 0.f}));
#pragma unroll
            for (int kk = 1; kk < 3; ++kk)
#pragma unroll
                for (int jt = 0; jt < 8; ++jt) s[jt] = MFMA16(kf[jt][kk], qf[kk], s[jt]);
            SCHED_FENCE();
        }
        u32x2 va[4][4], vb[4][4];
#pragma unroll
        for (int kk = 0; kk < 4; ++kk)
#pragma unroll
            for (int pt = 0; pt < 4; ++pt) { const LAS bf16_t* vr = sVT + (16 * pt + fr) * 136; const int sw = 8 * ((2 * pt + (fr >> 3)) & 7); va[kk][pt] = *(const LAS u32x2*)(vr + ((32 * kk + 4 * fq) ^ sw)); vb[kk][pt] = *(const LAS u32x2*)(vr + ((32 * kk + 16 + 4 * fq) ^ sw)); }
        SCHED_FENCE();
#pragma unroll
        for (int jt = 0; jt < 8; ++jt) mx = fmaxf(mx, fmaxf(fmaxf(s[jt][0], s[jt][1]), fmaxf(s[jt][2], s[jt][3])));
        mx = fmaxf(mx, __shfl_xor(mx, 16)); mx = fmaxf(mx, __shfl_xor(mx, 32));
        const float m_new = fmaxf(m_run, mx), alpha = __builtin_amdgcn_exp2f(m_run - m_new); m_run = m_new;
        float ls = 0.f;
#pragma unroll
        for (int jt = 0; jt < 8; ++jt)
#pragma unroll
            for (int e = 0; e < 4; ++e) { s[jt][e] = __builtin_amdgcn_exp2f(s[jt][e] - m_new); ls += s[jt][e]; }
        l_run = l_run * alpha + ls;
#pragma unroll
        for (int pt = 0; pt < 4; ++pt) o[pt] = o[pt] * alpha;
        bf16x8 yp[4];
#pragma unroll
        for (int kk = 0; kk < 4; ++kk) { u32x4 yw; yw.x = pk2(s[2 * kk][0], s[2 * kk][1]); yw.y = pk2(s[2 * kk][2], s[2 * kk][3]); yw.z = pk2(s[2 * kk + 1][0], s[2 * kk + 1][1]); yw.w = pk2(s[2 * kk + 1][2], s[2 * kk + 1][3]);
            yp[kk] = __builtin_bit_cast(bf16x8, yw); }
        SCHED_FENCE();
#pragma unroll
        for (int kk = 0; kk < 4; ++kk)
#pragma unroll
            for (int pt = 0; pt < 4; ++pt) { const u32x4 xw = (u32x4){va[kk][pt].x, va[kk][pt].y, vb[kk][pt].x, vb[kk][pt].y}; o[pt] = MFMA16(__builtin_bit_cast(bf16x8, xw), yp[kk], o[pt]); }
        SCHED_FENCE();
    }
#undef ATT_ISSUE
    float l = l_run + __shfl_xor(l_run, 16); l += __shfl_xor(l, 32); const float inv = 1.0f / l;
    if (MODE != 0 && l != 12345.678f) return;
    bf16_t* orow = C.abuf() + rq * 1024 + 768 + h * 64;
#pragma unroll
    for (int pt = 0; pt < 4; ++pt) { u32x2 w; w.x = pk2(o[pt][0] * inv, o[pt][1] * inv); w.y = pk2(o[pt][2] * inv, o[pt][3] * inv); *(u32x2*)(orow + 16 * pt + 4 * fq) = w; }
}

__device__ __forceinline__ int mix_unit_of(int bid, int G, int k) {
    if (G != 256) { const int idx = bid + k * G; return idx < 1472 ? idx : -1; }
    if (k == 0) return bid;
    if (bid < 192) {
        if (k == 1) return 256 + bid;
        if (k == 2 || k == 3) return 448 + 384 + 2 * bid + (k - 2);
        if (k == 4) return 448 + 768 + 64 + bid;
        return -1; }
    const int j = bid - 192;
    if (k <= 6) return 448 + 6 * j + (k - 1);
    if (k == 7) return 448 + 768 + j;
    return -1;
}
__device__ __forceinline__ void phase_mixers(Ctx& C, int layer) {
    for (int k = 0;; ++k) {
        int idx = mix_unit_of(C.bid, C.G, k); if (idx < 0) break;
        if (idx < 256) { const int rest = idx >> 3; attn_unit<0>(C, false, idx & 7, rest >> 3, rest & 7); continue; }
        idx -= 256;
        if (idx < 192) { const int b = idx & 7, rem = idx >> 3;
            if (rem < 16) scan_unit(C, layer, 0, false, b, rem >> 1, rem & 1); else scan_unit(C, layer, 1, false, b, (rem - 16) >> 1, rem & 1);
            continue; }
        idx -= 192;
        if (idx < 512) { scan_unit(C, layer, 0, true, idx >> 4, (idx >> 1) & 7, idx & 1); continue; }
        idx -= 512;
        if (idx < 256) { scan_unit(C, layer, 1, true, idx >> 3, (idx >> 1) & 3, idx & 1); continue; }
        idx -= 256;
        attn_unit<0>(C, true, idx >> 3, (idx >> 1) & 3, idx & 1);
    }
}

__device__ __forceinline__ void phase_mix(Ctx& C, int layer) {
    TIDS;
    const int gw = C.bid * NWAVES + wave, NGW = C.G * NWAVES;
    const float Dh = C.in(16)[layer * 8 + (lane >> 3)];
    const f32x4 nw0 = *(const f32x4*)(C.in(17) + layer * 512 + 8 * lane), nw1 = *(const f32x4*)(C.in(17) + layer * 512 + 8 * lane + 4);
    const f32x4 gw4 = *(const f32x4*)(C.in(19) + layer * 256 + 4 * lane);
    for (int r0 = gw; r0 < NTOK; r0 += 2 * NGW) {
        u32x4 yf[2], yb[2], xs[2], z[2]; u32x2 of[2], ob[2], g[2]; int rr[2];
#pragma unroll
        for (int q = 0; q < 2; ++q) { const int r = xcd_row(r0 + q * NGW < NTOK ? r0 + q * NGW : r0, C.G); rr[q] = r; const bf16_t* ur = C.ub() + (size_t)r * UP;
            yf[q] = *(const u32x4*)(C.yssd() + (size_t)r * 512 + 8 * lane); yb[q] = *(const u32x4*)(C.yssd() + (size_t)(NTOK + r) * 512 + 8 * lane);
            xs[q] = *(const u32x4*)(C.xbc() + (size_t)r * 768 + 8 * lane); z[q] = *(const u32x4*)(ur + 8 * lane);
            of[q] = *(const u32x2*)(C.yret() + (size_t)r * 256 + 4 * lane); ob[q] = *(const u32x2*)(C.yret() + (size_t)(NTOK + r) * 256 + 4 * lane); g[q] = *(const u32x2*)(ur + U_RG + 4 * lane); }
#pragma unroll
        for (int q = 0; q < 2; ++q) { const int r = rr[q];
          { const unsigned yfa[4] = {yf[q].x, yf[q].y, yf[q].z, yf[q].w}, yba[4] = {yb[q].x, yb[q].y, yb[q].z, yb[q].w}, xsa[4] = {xs[q].x, xs[q].y, xs[q].z, xs[q].w}, za[4] = {z[q].x, z[q].y, z[q].z, z[q].w};
            float v[8]; float ss = 0.f;
#pragma unroll
            for (int e = 0; e < 4; ++e) { v[2 * e] = (bflo(yfa[e]) + bflo(yba[e]) + Dh * bflo(xsa[e])) * pg8::silu_f(bflo(za[e])); v[2 * e + 1] = (bfhi(yfa[e]) + bfhi(yba[e]) + Dh * bfhi(xsa[e])) * pg8::silu_f(bfhi(za[e]));
                ss += v[2 * e] * v[2 * e] + v[2 * e + 1] * v[2 * e + 1]; }
            const float rstd = rsqrtf(wave_sum(ss) * (1.f / 512) + EPS);
            u32x4 o; o.x = pk2(v[0] * rstd * nw0.x, v[1] * rstd * nw0.y); o.y = pk2(v[2] * rstd * nw0.z, v[3] * rstd * nw0.w); o.z = pk2(v[4] * rstd * nw1.x, v[5] * rstd * nw1.y); o.w = pk2(v[6] * rstd * nw1.z, v[7] * rstd * nw1.w);
            *(u32x4*)(C.abuf() + (size_t)r * 1024 + 8 * lane) = o; }
          { const float o0 = bflo(of[q].x) + bflo(ob[q].x), o1 = bfhi(of[q].x) + bfhi(ob[q].x), o2 = bflo(of[q].y) + bflo(ob[q].y), o3 = bfhi(of[q].y) + bfhi(ob[q].y);
            const float s4 = row16_sum((o0 + o1) + (o2 + o3));
            const float mu = s4 * (1.f / 64); const float d0 = o0 - mu, d1 = o1 - mu, d2 = o2 - mu, d3 = o3 - mu; const float vq = row16_sum((d0 * d0 + d1 * d1) + (d2 * d2 + d3 * d3));
            const float rs = rsqrtf(vq * (1.f / 64) + EPS);
            u32x2 o; o.x = pk2(d0 * rs * gw4.x * pg8::silu_f(bflo(g[q].x)), d1 * rs * gw4.y * pg8::silu_f(bfhi(g[q].x))); o.y = pk2(d2 * rs * gw4.z * pg8::silu_f(bflo(g[q].y)), d3 * rs * gw4.w * pg8::silu_f(bfhi(g[q].y)));
            *(u32x2*)(C.abuf() + (size_t)r * 1024 + 512 + 4 * lane) = o; }
        }
    }
}

#define XB_TMO      128
#define XB_XCNT(j)  (256  + 64 * (j))
#define XB_XSUB(j)  (1280 + 64 * (j))
#define XB_XGEN(j)  (2304 + 64 * (j))
#define XB_TOP      3328
#define XB_TOPGEN   3392
#define XCD_BAR_WORDS 3456
#define XB_SPIN_CAP (1u << 18)
__device__ __forceinline__ unsigned xb_ld(unsigned* p)              { return __hip_atomic_load(p, __ATOMIC_RELAXED, __HIP_MEMORY_SCOPE_AGENT); }
__device__ __forceinline__ unsigned xb_add(unsigned* p, unsigned v) { return __hip_atomic_fetch_add(p, v, __ATOMIC_RELAXED, __HIP_MEMORY_SCOPE_AGENT); }
__device__ __forceinline__ unsigned xb_xcc_id() { return (unsigned)__builtin_amdgcn_s_getreg((3 << 11) | 20) & 0xFu; }
#define XB_SPIN(cond, bar) do { unsigned _sp = 0; while (cond) { __builtin_amdgcn_s_sleep(1); \
    if ((++_sp & 255u) == 0u) { if (xb_ld(&(bar)[XB_TMO])) break; if (_sp > XB_SPIN_CAP) { atomicAdd(&(bar)[XB_TMO], 1u); break; } } } } while (0)
struct XcdBarrier { unsigned* bar; unsigned x; volatile LAS unsigned* st; };
__device__ __forceinline__ XcdBarrier xcd_barrier_post(unsigned* bar, volatile LAS unsigned* st) {
    XcdBarrier b; b.bar = bar; b.x = xb_xcc_id(); b.st = st;
    if (threadIdx.x == 0) (void)xb_add(&bar[XB_XCNT(b.x)], 1u);
    return b;
}
__device__ __forceinline__ void xcd_barrier_complete(unsigned* bar, unsigned x, unsigned& nloc, unsigned& nx) {
    const unsigned G = gridDim.x * gridDim.y * gridDim.z;
    unsigned sum, cnt, mine, sp = 0u;
    for (;;) {
        sum = 0u; cnt = 0u; mine = 0u;
#pragma unroll
        for (unsigned j = 0; j < 16; ++j) { const unsigned c = xb_ld(&bar[XB_XCNT(j)]); sum += c; cnt += (c > 0u) ? 1u : 0u; mine = (j == x) ? c : mine; }
        if (sum == G) break;
        __builtin_amdgcn_s_sleep(1);
        if ((++sp & 255u) == 0u) { if (xb_ld(&bar[XB_TMO])) break; if (sp > XB_SPIN_CAP) { atomicAdd(&bar[XB_TMO], 1u); break; } }
    }
    nloc = mine > 0u ? mine : 1u; nx = cnt > 0u ? cnt : 1u;
}
__device__ __forceinline__ void xcd_barrier(const XcdBarrier& b) {
    asm volatile("s_waitcnt vmcnt(0)" ::: "memory");
    __syncthreads();
    if (threadIdx.x == 0) {
        unsigned* bar = b.bar;
        __builtin_amdgcn_s_waitcnt(0);
        unsigned nloc = b.st[0], nx = b.st[1];
        if (nloc == 0u) { xcd_barrier_complete(bar, b.x, nloc, nx); b.st[0] = nloc; b.st[1] = nx; }
        const unsigned old = xb_add(&bar[XB_XSUB(b.x)], 1u);
        const unsigned gen = old / nloc;
        if (old + 1u == (gen + 1u) * nloc) {
            __builtin_amdgcn_fence(__ATOMIC_RELEASE, "agent");
            asm volatile("s_waitcnt vmcnt(0)" ::: "memory");
            const unsigned og = xb_add(&bar[XB_TOP], 1u);
            const unsigned tg = og / nx;
            if (og + 1u == (tg + 1u) * nx) xb_add(&bar[XB_TOPGEN], 1u);
            else XB_SPIN(xb_ld(&bar[XB_TOPGEN]) == tg, bar);
            __builtin_amdgcn_fence(__ATOMIC_ACQUIRE, "agent");
            xb_add(&bar[XB_XGEN(b.x)], 1u);
            asm volatile("s_waitcnt vmcnt(0)" ::: "memory");
        } else {
            XB_SPIN(xb_ld(&bar[XB_XGEN(b.x)]) == gen, bar);
            __builtin_amdgcn_fence(__ATOMIC_ACQUIRE, "agent");
            asm volatile("s_waitcnt vmcnt(0)" ::: "memory");
        }
    }
    __syncthreads();
}
constexpr int MISC_OFF = 141312;
constexpr size_t WS_BAR = 65536;

constexpr int NSUB = 9, NPHASE = 2 + NSUB * DEPTH;

__global__ void __launch_bounds__(NTHR) mk_fwd(Args args) {
    extern __shared__ __attribute__((aligned(16))) unsigned char lds_raw[];
    {
        LAS unsigned long long* ptab = (LAS unsigned long long*)((LAS unsigned char*)lds_raw + PT_OFF);
        if (threadIdx.x < 29) ptab[threadIdx.x] = (unsigned long long)args.in[threadIdx.x];
        if (threadIdx.x < 32) ((LAS unsigned*)((LAS unsigned char*)lds_raw + MISC_OFF))[threadIdx.x] = 0u;
        __syncthreads();
    }
    XcdBarrier xbar; xbar.bar = (unsigned*)(args.ws + WS_BAR); xbar.x = 0; xbar.st = nullptr;
    if (MK_SINGLE) xbar = xcd_barrier_post((unsigned*)(args.ws + WS_BAR), (volatile LAS unsigned*)((LAS unsigned char*)lds_raw + MISC_OFF) + 8);
    cg::grid_group grid = cg::this_grid();
    int probe_rep = 0;
    for (int ph = args.ph_lo; ph < args.ph_hi; ++ph) {
        Ctx C; C.lds = (LAS unsigned char*)lds_raw; C.G = gridDim.x; C.bid = blockIdx.x;
        { GAS unsigned char* ws_ = (GAS unsigned char*)args.ws; GAS float* out_ = (GAS float*)args.out; asm volatile("" : "+s"(ws_), "+s"(out_)); C.ws = (unsigned char*)ws_; C.out = (float*)out_; }
        if (ph == 0) phase_prologue(C);
        else if (ph == NPHASE - 1) phase_norm_b<1>(C, C.in(28), nullptr, 0, 0);
        else {
            const int layer = (ph - 1) / NSUB, sub = (ph - 1) % NSUB;
            const float* modl = C.mod() + (size_t)layer * 9 * 6144; bf16_t* wl = C.wts() + (size_t)layer * WL_TOTAL;
            switch (sub) {
            case 0: if (layer == 0) phase_norm<0>(C, C.in(0), C.in(1), C.in(10), modl, 0, 1024); else phase_norm_b<0>(C, C.in(10) + layer * DM, modl, 0, 1024); break;
            case 1: { pg8::Gemm g{C.abuf(), wl + WL_IN, NTOK, UP, DM}; pg8::StaticOrder S; S.init(NTOK, UP, C.G, C.bid); pg8::EpiBf16 E{C.ub(), UP};
                      pg8::gemm_phase<pg8::EpiBf16, pg8::StaticOrder, true, true>(C.lds, g, S, E);
                      if (layer == 0) {
                          const int rem = S.nwg % C.G; const bool all = rem == 0;
                          if (all || C.bid >= rem) { TIDS; (void)tid; __syncthreads(); convert_weights(C, 0, ((all ? C.bid : C.bid - rem)) * NWAVES + wave, (all ? C.G : C.G - rem) * NWAVES, wave, lane, 2); }
                      } } break;
            case 2: phase_prep(C, layer); break;
            case 3: phase_mixers(C, layer); break;
            case 4: phase_mix(C, layer); break;
            case 5: { pg8::Gemm g{C.abuf(), wl + WL_OUT, NTOK, DM, DM}; pg8::StaticOrder S; S.init(NTOK, DM, C.G, C.bid); pg8::EpiRes E{layer == 0 ? C.in(0) : nullptr, layer == 0 ? C.in(1) : nullptr, C.xb(), modl + 2048};
                      pg8::gemm_phase<pg8::EpiRes, pg8::StaticOrder, false, true>(C.lds, g, S, E); } break;
            case 6: phase_norm_b<0>(C, C.in(25) + layer * DM, modl, 3072, 4096); break;
            case 7: { pg8::Gemm g{C.abuf(), wl + WL_W1, NTOK, 2 * DFF, DM}; pg8::StaticOrder S; S.init(NTOK, 2 * DFF, C.G, C.bid); pg8::EpiSwiGLU E{C.ub(), DFF};
                      pg8::gemm_phase<pg8::EpiSwiGLU, pg8::StaticOrder, true, true>(C.lds, g, S, E);
                      if (layer + 1 < DEPTH) {
                          const int rem = S.nwg % C.G; const bool all = rem == 0;
                          if (all || C.bid >= rem) { TIDS; (void)tid; __syncthreads(); if (layer == 0) convert_weights(C, 0, ((all ? C.bid : C.bid - rem)) * NWAVES + wave, (all ? C.G : C.G - rem) * NWAVES, wave, lane, 3); convert_weights(C, layer + 1, ((all ? C.bid : C.bid - rem)) * NWAVES + wave, (all ? C.G : C.G - rem) * NWAVES, wave, lane); }
                      } } break;
            case 8: { pg8::Gemm g{C.ub(), wl + WL_W2, NTOK, DM, DFF}; pg8::StaticOrder S; S.init(NTOK, DM, C.G, C.bid); pg8::EpiRes E{nullptr, nullptr, C.xb(), modl + 5120};
                      pg8::gemm_phase<pg8::EpiRes, pg8::StaticOrder, false, true>(C.lds, g, S, E); } break;
            }
        }
        if (ph + 1 < args.ph_hi) { if (args.ph_hi > 1000) grid.sync(); else xcd_barrier(xbar); }
        if (PROBE_SUB >= 0) { if (((ph > 0 && ph < NPHASE - 1 && (ph - 1) % NSUB == PROBE_SUB) || (PROBE_SUB == 100 && ph == 0)) && probe_rep == 0) { probe_rep = 1; --ph; } else probe_rep = 0; }
    }
}

extern "C" void kernel_launch(void* const* d_in, const int* in_sizes, int n_in, void* d_out, int out_size, void* d_ws, size_t ws_size, hipStream_t stream) {
    static int grid = 0;
    if (grid == 0) {
        if (n_in != 29 || ws_size < WS_END) { fprintf(stderr, "kernel_launch: unexpected inputs (n_in %d) or workspace %zu < %zu\n", n_in, ws_size, (size_t)WS_END); grid = -1; return; }
        int dev = 0, cus = 0, per_cu = 0;
        hipGetDevice(&dev); hipDeviceGetAttribute(&cus, hipDeviceAttributeMultiprocessorCount, dev);
        hipFuncSetAttribute((const void*)mk_fwd, hipFuncAttributeMaxDynamicSharedMemorySize, LDS_BYTES);
        hipOccupancyMaxActiveBlocksPerMultiprocessor(&per_cu, (const void*)mk_fwd, NTHR, LDS_BYTES);
        if (per_cu < 1) { fprintf(stderr, "kernel_launch: occupancy query says %d blocks per CU\n", per_cu); per_cu = 1; }
        (void)hipGetLastError();
        grid = cus * 1;
    }
    if (grid < 0) return;
    Args a{};
    for (int i = 0; i < 29; ++i) a.in[i] = (const float*)d_in[i];
    a.out = (float*)d_out; a.ws = (unsigned char*)d_ws;
#if MK_SINGLE
    if (hipMemsetAsync(d_ws, 0, 1u << 20, stream) != hipSuccess) { fprintf(stderr, "kernel_launch: memset failed\n"); return; }
    a.ph_lo = 0; a.ph_hi = NPHASE;
    void* kargs[] = {&a};
    hipError_t e = hipLaunchCooperativeKernel((const void*)mk_fwd, dim3(grid), dim3(NTHR), kargs, LDS_BYTES, stream);
    if (e != hipSuccess) fprintf(stderr, "cooperative launch failed: %s (grid %d)\n", hipGetErrorString(e), grid);
#else
    for (int ph = 0; ph < NPHASE; ++ph) { a.ph_lo = ph; a.ph_hi = ph + 1; hipLaunchKernelGGL(mk_fwd, dim3(grid), dim3(NTHR), LDS_BYTES, stream, a); }
#endif
}
```
